# Optimizing an MI355X kernel written in HIP

```python
import math, functools
import jax, jax.numpy as jnp
from jax import lax
import numpy as np

D_MODEL = 1024
BATCH = 2
SEQ = 8192
DEPTH = 2
DEC_BATCH = 128
DEC_SEQ = 1
PAST_LEN = 8192
PAGE_SIZE = 128

BRANCH_W = D_MODEL // 2
HEAD_DIM = 64
N_HEADS = BRANCH_W // HEAD_DIM
KV_HEADS = 2
GQA_GROUP = N_HEADS // KV_HEADS
WINDOW = 128
ATTN_BLOCK = WINDOW
Q_W = N_HEADS * HEAD_DIM
KV_W = KV_HEADS * HEAD_DIM
SSM_GROUP_CH = 16
SSM_GROUPS = BRANCH_W // SSM_GROUP_CH
SSM_STATE = 64
CHUNK = 128
SGU_GROUPS = 4
N_BRANCH = 3
IN_SIZES = (Q_W, KV_W, KV_W, BRANCH_W, BRANCH_W, BRANCH_W, BRANCH_W, BRANCH_W, BRANCH_W, N_BRANCH * D_MODEL)
N_IN = sum(IN_SIZES)
ALPHA = (2 * DEPTH) ** 0.25
BETA = (8 * DEPTH) ** -0.25
LN_EPS = 1e-5
ATTN_SCALE = HEAD_DIM ** -0.5
NEG_INF = -1e30

kernel_name = 'hybrid_swa_s5_sgu_decoder_step'


def _layernorm(x, g, b):
    xf = x.astype(jnp.float32)
    xc = xf - xf.mean(-1, keepdims=True)
    var = (xc * xc).mean(-1, keepdims=True)
    y = xc * lax.rsqrt(var + LN_EPS) * g.astype(jnp.float32) + b.astype(jnp.float32)
    return y.astype(x.dtype)


def _alibi_slopes():
    h = jnp.arange(1, N_HEADS + 1, dtype=jnp.float32)
    return jnp.exp2(-8.0 * h / N_HEADS)


def _window_attention(q, k, v, qpos, kpos, sinks):
    nb, m, tq = q.shape[:3]
    qg = q.reshape(nb, m, tq, KV_HEADS, GQA_GROUP, HEAD_DIM)
    s = jnp.einsum('bmqkgd,bmskd->bmkgqs', qg, k, preferred_element_type=jnp.float32) * ATTN_SCALE
    dist = qpos[:, :, None] - kpos[:, None, :]
    valid = (dist >= 0) & (dist <= WINDOW) & (kpos[:, None, :] >= 0)
    slopes = _alibi_slopes().reshape(KV_HEADS, GQA_GROUP)
    bias = -slopes[None, None, :, :, None, None] * dist.astype(jnp.float32)[None, :, None, None]
    s = jnp.where(valid[None, :, None, None], s + bias, NEG_INF)
    sink = sinks.astype(jnp.float32).reshape(KV_HEADS, GQA_GROUP)[None, None, :, :, None, None]
    mx = jnp.maximum(s.max(-1, keepdims=True), sink)
    p = jnp.exp(s - mx)
    denom = p.sum(-1, keepdims=True) + jnp.exp(sink - mx)
    p = (p / denom).astype(v.dtype)
    o = jnp.einsum('bmkgqs,bmskd->bmqkgd', p, v)
    return o.reshape(nb, m, tq, Q_W)


def _attend_prompt(q, k, v, sinks):
    n, t = q.shape[:2]
    nb = t // ATTN_BLOCK
    qb = q.reshape(n, nb, ATTN_BLOCK, N_HEADS, HEAD_DIM)
    kb = k.reshape(n, nb, ATTN_BLOCK, KV_HEADS, HEAD_DIM)
    vb = v.reshape(n, nb, ATTN_BLOCK, KV_HEADS, HEAD_DIM)
    shift = ((0, 0), (1, 0), (0, 0), (0, 0), (0, 0))
    kcat = jnp.concatenate([jnp.pad(kb[:, :-1], shift), kb], axis=2)
    vcat = jnp.concatenate([jnp.pad(vb[:, :-1], shift), vb], axis=2)
    pos = jnp.arange(t, dtype=jnp.int32).reshape(nb, ATTN_BLOCK)
    kpos = jnp.concatenate([pos - ATTN_BLOCK, pos], axis=1)
    o = _window_attention(qb, kcat, vcat, pos, kpos, sinks).reshape(n, t, Q_W)
    keep = min(WINDOW, t)
    return o, k[:, t - keep:], v[:, t - keep:]


def _attend_sample(q, k, v, sinks, cache_k, cache_v):
    t = q.shape[1]
    w = cache_k.shape[1]
    kcat = jnp.concatenate([cache_k.astype(k.dtype), k], axis=1)[:, None]
    vcat = jnp.concatenate([cache_v.astype(v.dtype), v], axis=1)[:, None]
    qpos = PAST_LEN + jnp.arange(t, dtype=jnp.int32)
    kpos = jnp.concatenate([PAST_LEN - w + jnp.arange(w, dtype=jnp.int32), qpos])
    o = _window_attention(q[:, None], kcat, vcat, qpos[None], kpos[None], sinks)[:, 0]
    return o, k, v


def _complex_affine_combine(e1, e2):
    a1r, a1i, b1r, b1i = e1
    a2r, a2i, b2r, b2i = e2
    return (a2r * a1r - a2i * a1i,
            a2r * a1i + a2i * a1r,
            a2r * b1r - a2i * b1i + b2r,
            a2r * b1i + a2i * b1r + b2i)


def _s5(u, h0_re, h0_im, lam_re, lam_im, log_dt, b_re, b_im, c_re, c_im, d_skip, glu_w, glu_b):
    f32 = jnp.float32
    n, t, _ = u.shape
    uf = u.astype(f32)
    ug = uf.reshape(n, t, SSM_GROUPS, SSM_GROUP_CH)
    lr = lam_re.astype(f32)
    li = lam_im.astype(f32)
    dt = jnp.exp(log_dt.astype(f32))[:, None]
    mag = jnp.exp(lr * dt)
    ar = mag * jnp.cos(li * dt)
    ai = mag * jnp.sin(li * dt)
    den = lr * lr + li * li
    cr = ((ar - 1.0) * lr + ai * li) / den
    ci = (ai * lr - (ar - 1.0) * li) / den
    br = b_re.astype(f32)
    bi = b_im.astype(f32)
    bbr = cr[..., None] * br - ci[..., None] * bi
    bbi = cr[..., None] * bi + ci[..., None] * br
    xr = jnp.einsum('ntgh,gph->ntgp', ug, bbr)
    xi = jnp.einsum('ntgh,gph->ntgp', ug, bbi)
    h0r = h0_re.astype(f32)
    h0i = h0_im.astype(f32)
    xr = xr.at[:, 0].add(ar * h0r - ai * h0i)
    xi = xi.at[:, 0].add(ar * h0i + ai * h0r)
    a_r = jnp.broadcast_to(ar, xr.shape)
    a_i = jnp.broadcast_to(ai, xi.shape)
    _, _, hr, hi = lax.associative_scan(_complex_affine_combine, (a_r, a_i, xr, xi), axis=1)
    y = (jnp.einsum('ntgp,ghp->ntgh', hr, c_re.astype(f32))
         - jnp.einsum('ntgp,ghp->ntgh', hi, c_im.astype(f32)))
    y = y.reshape(n, t, BRANCH_W) + d_skip.astype(f32) * uf
    y = jax.nn.gelu(y)
    y = y * jax.nn.sigmoid(jnp.einsum('ntw,wv->ntv', y, glu_w.astype(f32)) + glu_b.astype(f32))
    return y.astype(u.dtype), hr[:, -1], hi[:, -1]


def _chunk_sgu(u, v, ln_g, ln_b, ws, bs):
    n, t, w = v.shape
    vn = _layernorm(v, ln_g, ln_b)
    pad = (-t) % CHUNK
    vp = jnp.pad(vn, ((0, 0), (0, pad), (0, 0)))
    nc = (t + pad) // CHUNK
    vc = vp.reshape(n, nc, CHUNK, SGU_GROUPS, w // SGU_GROUPS)
    tril = jnp.tril(jnp.ones((CHUNK, CHUNK), dtype=bool))
    wm = jnp.where(tril[None], ws, jnp.zeros_like(ws))
    s = jnp.einsum('gts,ncsgw->nctgw', wm, vc) + bs.T[None, None, :, :, None]
    s = s.reshape(n, nc * CHUNK, w)[:, :t]
    return u * s, vn


def _layer(x, attend, h0_re, h0_im, w_in, sinks, lam_re, lam_im, log_dt, b_re, b_im, c_re, c_im,
           d_skip, glu_w, glu_b, sgu_ln_g, sgu_ln_b, sgu_w, sgu_b, w_read, w_o, ln_g, ln_b):
    n, t, _ = x.shape
    proj = jnp.einsum('ntd,de->nte', x, w_in)
    cuts = [int(c) for c in np.cumsum(IN_SIZES)[:-1]]
    q, k, v, z_a, u_b, z_b, u_c, v_c, z_c, g = jnp.split(proj, cuts, axis=-1)
    q = q.reshape(n, t, N_HEADS, HEAD_DIM)
    k = k.reshape(n, t, KV_HEADS, HEAD_DIM)
    v = v.reshape(n, t, KV_HEADS, HEAD_DIM)
    y_a, k_rows, v_rows = attend(q, k, v, sinks)
    y_b, h_re, h_im = _s5(u_b, h0_re, h0_im, lam_re, lam_im, log_dt, b_re, b_im, c_re, c_im,
                          d_skip, glu_w, glu_b)
    y_c, vn_rows = _chunk_sgu(u_c, v_c, sgu_ln_g, sgu_ln_b, sgu_w, sgu_b)
    ys = jnp.stack([y_a * jax.nn.silu(z_a), y_b * jax.nn.silu(z_b), y_c * jax.nn.silu(z_c)], axis=2)
    branch = jnp.einsum('ntbw,bwd->ntbd', ys, w_read)
    gates = jax.nn.sigmoid(g.reshape(n, t, N_BRANCH, D_MODEL))
    merged = (gates * branch).sum(axis=2)
    out = jnp.einsum('ntd,de->nte', merged, w_o)
    x = _layernorm(ALPHA * x + out, ln_g, ln_b)
    return x, (k_rows, v_rows, h_re, h_im, vn_rows)


def setup_inputs(seed: int = 0) -> dict:
    key = jax.random.key(seed)
    ks = jax.random.split(key, 26)
    f32 = jnp.float32

    def nrm(k, shape, scale):
        return scale * jax.random.normal(k, shape, f32)

    win_buf = min(WINDOW, PAST_LEN)
    lam_im_base = jnp.pi * jnp.arange(SSM_STATE, dtype=f32)
    return {
        'x_prompt': nrm(ks[0], (BATCH, SEQ, D_MODEL), 1.0),
        'x_sample': nrm(ks[1], (DEC_BATCH, DEC_SEQ, D_MODEL), 1.0),
        'cache_k_win': nrm(ks[2], (DEPTH, DEC_BATCH, win_buf, KV_HEADS, HEAD_DIM), 1.0),
        'cache_v_win': nrm(ks[3], (DEPTH, DEC_BATCH, win_buf, KV_HEADS, HEAD_DIM), 1.0),
        'state_ssm_re': nrm(ks[4], (DEPTH, DEC_BATCH, SSM_GROUPS, SSM_STATE), 0.3),
        'state_ssm_im': nrm(ks[5], (DEPTH, DEC_BATCH, SSM_GROUPS, SSM_STATE), 0.3),
        'w_in': nrm(ks[6], (DEPTH, D_MODEL, N_IN), D_MODEL ** -0.5),
        'attn_sinks': nrm(ks[7], (DEPTH, N_HEADS), 0.5),
        'ssm_lambda_re': -0.5 + nrm(ks[8], (DEPTH, SSM_GROUPS, SSM_STATE), 0.01),
        'ssm_lambda_im': lam_im_base + nrm(ks[9], (DEPTH, SSM_GROUPS, SSM_STATE), 0.01),
        'ssm_log_dt': jax.random.uniform(ks[10], (DEPTH, SSM_GROUPS), f32,
                                         minval=math.log(1e-3), maxval=math.log(1e-1)),
        'ssm_b_re': nrm(ks[11], (DEPTH, SSM_GROUPS, SSM_STATE, SSM_GROUP_CH), (2 * SSM_GROUP_CH) ** -0.5),
        'ssm_b_im': nrm(ks[12], (DEPTH, SSM_GROUPS, SSM_STATE, SSM_GROUP_CH), (2 * SSM_GROUP_CH) ** -0.5),
        'ssm_c_re': nrm(ks[13], (DEPTH, SSM_GROUPS, SSM_GROUP_CH, SSM_STATE), SSM_STATE ** -0.5),
        'ssm_c_im': nrm(ks[14], (DEPTH, SSM_GROUPS, SSM_GROUP_CH, SSM_STATE), SSM_STATE ** -0.5),
        'ssm_d': nrm(ks[15], (DEPTH, BRANCH_W), 1.0),
        'glu_w': nrm(ks[16], (DEPTH, BRANCH_W, BRANCH_W), BRANCH_W ** -0.5),
        'glu_b': nrm(ks[17], (DEPTH, BRANCH_W), 0.02),
        'sgu_ln_g': 1.0 + nrm(ks[18], (DEPTH, BRANCH_W), 0.02),
        'sgu_ln_b': nrm(ks[19], (DEPTH, BRANCH_W), 0.02),
        'sgu_w': nrm(ks[20], (DEPTH, SGU_GROUPS, CHUNK, CHUNK), 0.5 * CHUNK ** -0.5),
        'sgu_b': 1.0 + nrm(ks[21], (DEPTH, SGU_GROUPS, CHUNK), 0.02),
        'w_read': nrm(ks[22], (DEPTH, N_BRANCH, BRANCH_W, D_MODEL), BRANCH_W ** -0.5),
        'w_o': nrm(ks[23], (DEPTH, D_MODEL, D_MODEL), BETA * D_MODEL ** -0.5),
        'ln_g': 1.0 + nrm(ks[24], (DEPTH, D_MODEL), 0.02),
        'ln_b': nrm(ks[25], (DEPTH, D_MODEL), 0.02),
    }


def reference(x_prompt, x_sample, cache_k_win, cache_v_win, state_ssm_re, state_ssm_im,
              w_in, attn_sinks, ssm_lambda_re, ssm_lambda_im, ssm_log_dt, ssm_b_re, ssm_b_im,
              ssm_c_re, ssm_c_im, ssm_d, glu_w, glu_b, sgu_ln_g, sgu_ln_b, sgu_w, sgu_b,
              w_read, w_o, ln_g, ln_b):
    xp = x_prompt
    xs = x_sample
    h0 = jnp.zeros((x_prompt.shape[0], SSM_GROUPS, SSM_STATE), jnp.float32)
    kp, vp, hrp, hip = [], [], [], []
    ksm, vsm, hrs, his, vcs = [], [], [], [], []
    for l in range(DEPTH):
        lw = (w_in[l], attn_sinks[l], ssm_lambda_re[l], ssm_lambda_im[l], ssm_log_dt[l],
              ssm_b_re[l], ssm_b_im[l], ssm_c_re[l], ssm_c_im[l], ssm_d[l], glu_w[l], glu_b[l],
              sgu_ln_g[l], sgu_ln_b[l], sgu_w[l], sgu_b[l], w_read[l], w_o[l], ln_g[l], ln_b[l])
        xp, (k_r, v_r, h_r, h_i, _) = _layer(xp, _attend_prompt, h0, h0, *lw)
        kp.append(k_r)
        vp.append(v_r)
        hrp.append(h_r)
        hip.append(h_i)
        attend_s = functools.partial(_attend_sample, cache_k=cache_k_win[l], cache_v=cache_v_win[l])
        xs, (k_r, v_r, h_r, h_i, vc) = _layer(xs, attend_s, state_ssm_re[l], state_ssm_im[l], *lw)
        ksm.append(k_r)
        vsm.append(v_r)
        hrs.append(h_r)
        his.append(h_i)
        vcs.append(vc)
    return (xp, xs, jnp.stack(kp), jnp.stack(vp), jnp.stack(hrp), jnp.stack(hip),
            jnp.stack(ksm), jnp.stack(vsm), jnp.stack(hrs), jnp.stack(his), jnp.stack(vcs))
```

```cpp
#include <hip/hip_runtime.h>
#include <hip/hip_cooperative_groups.h>
#include <cstdio>
#include <cstdint>
namespace cg = cooperative_groups;

#ifndef ML
#define ML 0
#endif

typedef unsigned short u16;
typedef short bf16x8 __attribute__((ext_vector_type(8)));
typedef short bf16x4 __attribute__((ext_vector_type(4)));
typedef float f32x4 __attribute__((ext_vector_type(4)));

constexpr int DM = 1024, TP = 16384, TS = 128, TT = TP + TS, SEQL = 8192, NPROJ = 3840, NIN = 6912;
constexpr int OQ = 0, OKK = 512, OV = 640, OZA = 768, OUB = 1280, OZB = 1792, OUC = 2304, OVC = 2816, OZC = 3328, OG = 3840;
constexpr float ALPHA_C = 1.41421356237f;

constexpr size_t WS_PROJ = 0;
constexpr size_t WS_XBF  = WS_PROJ + (size_t)TT * NPROJ * 2;
constexpr size_t WS_MRG  = WS_XBF + (size_t)TT * DM * 2;
constexpr size_t WS_WIN  = WS_MRG + (size_t)TT * DM * 2;
constexpr size_t WS_WR   = WS_WIN + (size_t)2 * NIN * DM * 2;
constexpr size_t WS_WO   = WS_WR + (size_t)2 * 3 * 1024 * 512 * 2;
constexpr size_t WS_GLU  = WS_WO + (size_t)2 * 1024 * 1024 * 2;
constexpr size_t WS_SGUW = WS_GLU + (size_t)2 * 512 * 512 * 2;
constexpr size_t WS_VT   = WS_SGUW + (size_t)2 * 4 * 128 * 128 * 2;
constexpr size_t WS_ABAR = WS_VT + (size_t)2 * 2 * 64 * 8192 * 2;
constexpr size_t WS_A128 = WS_ABAR + (size_t)2 * 32 * 64 * 2 * 4;
constexpr size_t WS_BBT  = WS_A128 + (size_t)2 * 32 * 64 * 2 * 4;
constexpr size_t WS_CMT  = WS_BBT + (size_t)2 * 32 * 128 * 16 * 2;
constexpr size_t WS_SST  = WS_CMT + (size_t)2 * 32 * 16 * 128 * 2;
constexpr size_t WS_GX   = WS_SST + (size_t)128 * 32 * 128 * 4;
constexpr size_t WS_BAR  = WS_GX + (size_t)TT * 256 * 2;
constexpr size_t WS_END  = WS_BAR + 16384;

constexpr size_t O_YP = 0, O_YS = 16777216, O_KP = 16908288, O_VP = 16973824, O_HRP = 17039360, O_HIP = 17047552,
                 O_KS = 17055744, O_VS = 17088512, O_HRS = 17121280, O_HIS = 17645568, O_VC = 18169856;

struct Params {
    const float* in[26];
    float* out;
    unsigned char* ws;
};

constexpr int SMEM_BYTES = 73728;
constexpr int LDT = 72;

__device__ __forceinline__ unsigned cvt_pk_bf16(float lo, float hi) { unsigned r; asm volatile("v_cvt_pk_bf16_f32 %0, %1, %2" : "=v"(r) : "v"(lo), "v"(hi)); return r; }
__device__ __forceinline__ u16 f2bf(float f) { return (u16)(cvt_pk_bf16(f, 0.f) & 0xffffu); }
__device__ __forceinline__ float bf2f(u16 h) { return __uint_as_float(((unsigned)h) << 16); }
__device__ __forceinline__ float bflo(unsigned w) { return __uint_as_float(w << 16); }
__device__ __forceinline__ float bfhi(unsigned w) { return __uint_as_float(w & 0xffff0000u); }
__device__ __forceinline__ float sigmoidf_(float x) { return 1.0f / (1.0f + __expf(-x)); }
__device__ __forceinline__ float siluf_(float x) { return x / (1.0f + __expf(-x)); }
__device__ __forceinline__ float geluf_(float y) { const float z = 0.7978845608f * (y + 0.044715f * y * y * y); return y / (1.0f + __expf(-2.0f * z)); }
__device__ __forceinline__ f32x4 mfma32(bf16x8 a, bf16x8 b, f32x4 c) { return __builtin_amdgcn_mfma_f32_16x16x32_bf16(a, b, c, 0, 0, 0); }
__device__ __forceinline__ f32x4 mfma16(bf16x4 a, bf16x4 b, f32x4 c) { return __builtin_amdgcn_mfma_f32_16x16x16bf16_1k(a, b, c, 0, 0, 0); }
__device__ __forceinline__ void store_bf4(u16* p, float a, float b, float c, float d) { uint2 w; w.x = cvt_pk_bf16(a, b); w.y = cvt_pk_bf16(c, d); *(uint2*)p = w; }
__device__ __forceinline__ int otid() { int t = threadIdx.x; asm volatile("" : "+v"(t)); return t; }
__device__ __forceinline__ float wave_sum(float v) {
#pragma unroll
    for (int o = 32; o > 0; o >>= 1) v += __shfl_xor(v, o);
    return v;
}
__device__ __forceinline__ float wave_max(float v) {
#pragma unroll
    for (int o = 32; o > 0; o >>= 1) v = fmaxf(v, __shfl_xor(v, o));
    return v;
}

__device__ __forceinline__ size_t wt_ofs(int n, int k, int K) { return ((size_t)((n >> 8) * (K >> 5) + (k >> 5))) * 8192 + (size_t)((n & 255) * 32 + (k & 31)); }

__device__ __forceinline__ size_t xt_ofs(int tok, int k) { return ((size_t)((tok >> 7) * 32 + (k >> 5))) * 4096 + (size_t)((tok & 127) * 32 + (k & 31)); }

template <int TM, int TN, int WM, int WN, bool WT = false, bool XT = false>
__device__ __forceinline__ void gemm_accum(f32x4 (&acc)[TM][TN], const u16* __restrict__ W, const int ldw,
                                           const u16* __restrict__ X, const int ldx, const int K, u16* lds, const int wn0 = 0) {
    constexpr int WR = 16 * TM * WM, XR = 16 * TN * WN, WCH = WR * 8, XCH = XR * 8;
    constexpr int NW = (WCH + 255) / 256, NX = (XCH + 255) / 256;
    static_assert(NW <= 4 && NX <= 4, "tile too large");
    u16* As = lds;
    u16* Bs = lds + 2 * WR * LDT;
    const int tid = otid(), lane = tid & 63, wid = tid >> 6, wm = wid / WN, wn = wid % WN, fr = lane & 15, fq = lane >> 4;
    const int lrow = tid >> 3, lcol = (tid & 7) * 8;
    const u16* Wp = W + (size_t)lrow * ldw + lcol;
    const u16* Xp = X + (size_t)lrow * ldx + lcol;
    uint4 rw0, rw1, rw2, rw3, rx0, rx1, rx2, rx3;
    rw0 = rw1 = rw2 = rw3 = rx0 = rx1 = rx2 = rx3 = make_uint4(0, 0, 0, 0);
#define GW_(j, k0) if (j < NW && ((WCH % 256 == 0) || (tid + 256 * j < WCH))) rw##j = WT ? *(const uint4*)(W + wt_ofs(wn0 + lrow + 32 * j, (k0) + lcol, ldw)) : *(const uint4*)(Wp + (size_t)(32 * j) * ldw + (k0));
#define GX_(j, k0) if (j < NX && ((XCH % 256 == 0) || (tid + 256 * j < XCH))) rx##j = XT ? *(const uint4*)(X + (size_t)(((k0) + lcol) >> 5) * 4096 + (lrow + 32 * j) * 32 + (((k0) + lcol) & 31)) : *(const uint4*)(Xp + (size_t)(32 * j) * ldx + (k0));
#define SW_(j, nb) if (j < NW && ((WCH % 256 == 0) || (tid + 256 * j < WCH))) *(uint4*)(As + (nb) * WR * LDT + (lrow + 32 * j) * LDT + lcol) = rw##j;
#define SX_(j, nb) if (j < NX && ((XCH % 256 == 0) || (tid + 256 * j < XCH))) *(uint4*)(Bs + (nb) * XR * LDT + (lrow + 32 * j) * LDT + lcol) = rx##j;
    GW_(0, 0) GW_(1, 0) GW_(2, 0) GW_(3, 0) GX_(0, 0) GX_(1, 0) GX_(2, 0) GX_(3, 0)
    SW_(0, 0) SW_(1, 0) SW_(2, 0) SW_(3, 0) SX_(0, 0) SX_(1, 0) SX_(2, 0) SX_(3, 0)
    __syncthreads();
    int nk = K >> 6;
    asm volatile("" : "+s"(nk));
    for (int kt = 0; kt < nk; ++kt) {
        const bool more = (kt + 1 < nk);
        if (more) {
            const int k0 = (kt + 1) << 6;
            GW_(0, k0) GW_(1, k0) GW_(2, k0) GW_(3, k0) GX_(0, k0) GX_(1, k0) GX_(2, k0) GX_(3, k0)
        }
        const u16* a_ = As + (kt & 1) * WR * LDT + (wm * TM * 16 + fr) * LDT + fq * 8;
        const u16* b_ = Bs + (kt & 1) * XR * LDT + (wn * TN * 16 + fr) * LDT + fq * 8;
#pragma unroll
        for (int ks = 0; ks < 2; ++ks) {
            bf16x8 bfr[TN];
#pragma unroll
            for (int j = 0; j < TN; ++j) bfr[j] = *(const bf16x8*)(b_ + j * 16 * LDT + ks * 32);
#pragma unroll
            for (int i = 0; i < TM; ++i) {
                const bf16x8 af = *(const bf16x8*)(a_ + i * 16 * LDT + ks * 32);
#pragma unroll
                for (int j = 0; j < TN; ++j) acc[i][j] = mfma32(af, bfr[j], acc[i][j]);
            }
        }
        if (more) {
            const int nb = (kt + 1) & 1;
            SW_(0, nb) SW_(1, nb) SW_(2, nb) SW_(3, nb) SX_(0, nb) SX_(1, nb) SX_(2, nb) SX_(3, nb)
        }
        __syncthreads();
    }
#undef GW_
#undef GX_
#undef SW_
#undef SX_
}


template <int OFF>
__device__ __forceinline__ bf16x8 lds_rd128(unsigned addr) {
    bf16x8 v;
    asm volatile("ds_read_b128 %0, %1 offset:%2" : "=v"(v) : "v"(addr), "n"(OFF) : "memory");
    return v;
}
template <bool XT>
__device__ __forceinline__ void gemm_big(f32x4 (&acc)[8][4], const u16* __restrict__ W, const int ldw,
                                         const u16* __restrict__ X, const int ldx, const int K, unsigned char* lds) {
    const int tid = otid(), lane = tid & 63, wid = tid >> 6, wm = wid >> 1, wn = wid & 1, fr = lane & 15, fq = lane >> 4;
    constexpr int STG = 24576;
    const u16* Wp = W + tid * 8;
    const u16* Xp = XT ? (X + tid * 8) : (X + (size_t)(tid >> 2) * ldx + (tid & 3) * 8);
    const size_t xs1 = XT ? (size_t)2048 : (size_t)64 * ldx; const int xks = XT ? 128 : 1;
    unsigned char* sdst = lds + tid * 16;
    const unsigned lbase = (unsigned)(size_t)(__attribute__((address_space(3))) unsigned char*)lds;
    const unsigned a_off = lbase + (wm * 128 + fr) * 64 + fq * 16;
    const unsigned b_off = lbase + 16384 + (wn * 64 + fr) * 64 + fq * 16;
#define BIG_ISSUE(stg, k0) { unsigned char* sb_ = sdst + (stg) * STG; \
        __builtin_amdgcn_global_load_lds((const unsigned*)(Wp + (size_t)(k0) * 256), (unsigned*)(sb_), 16, 0, 0); \
        __builtin_amdgcn_global_load_lds((const unsigned*)(Wp + (size_t)(k0) * 256 + 2048), (unsigned*)(sb_ + 4096), 16, 0, 0); \
        __builtin_amdgcn_global_load_lds((const unsigned*)(Wp + (size_t)(k0) * 256 + 4096), (unsigned*)(sb_ + 8192), 16, 0, 0); \
        __builtin_amdgcn_global_load_lds((const unsigned*)(Wp + (size_t)(k0) * 256 + 6144), (unsigned*)(sb_ + 12288), 16, 0, 0); \
        __builtin_amdgcn_global_load_lds((const unsigned*)(Xp + (size_t)(k0) * xks), (unsigned*)(sb_ + 16384), 16, 0, 0); \
        __builtin_amdgcn_global_load_lds((const unsigned*)(Xp + (size_t)(k0) * xks + xs1), (unsigned*)(sb_ + 20480), 16, 0, 0); }
    int nk = K >> 5;
    asm volatile("" : "+s"(nk));
    asm volatile("s_waitcnt vmcnt(0)" ::: "memory");
    BIG_ISSUE(0, 0)
    if (nk > 1) BIG_ISSUE(1, 32)
    int stage = 0;
    for (int kt = 0; kt < nk; ++kt) {
        if (kt + 1 < nk) asm volatile("s_waitcnt vmcnt(6)" ::: "memory"); else asm volatile("s_waitcnt vmcnt(0)" ::: "memory");
        __builtin_amdgcn_s_barrier();
        asm volatile("" ::: "memory");
        if (kt + 2 < nk) { int s2 = stage + 2; if (s2 >= 3) s2 -= 3; BIG_ISSUE(s2, (kt + 2) << 5) }
        const unsigned aa = a_off + stage * STG, bb = b_off + stage * STG;
        bf16x8 b0 = lds_rd128<0>(bb), b1 = lds_rd128<1024>(bb), b2 = lds_rd128<2048>(bb), b3 = lds_rd128<3072>(bb);
        bf16x8 a0 = lds_rd128<0>(aa), a1 = lds_rd128<1024>(aa), a2 = lds_rd128<2048>(aa), a3 = lds_rd128<3072>(aa);
        bf16x8 a4 = lds_rd128<4096>(aa), a5 = lds_rd128<5120>(aa), a6 = lds_rd128<6144>(aa), a7 = lds_rd128<7168>(aa);
#define BIG_ROW(i, av) acc[i][0] = mfma32(av, b0, acc[i][0]); acc[i][1] = mfma32(av, b1, acc[i][1]); acc[i][2] = mfma32(av, b2, acc[i][2]); acc[i][3] = mfma32(av, b3, acc[i][3]);
        asm volatile("s_waitcnt lgkmcnt(7)" : "+v"(b0), "+v"(b1), "+v"(b2), "+v"(b3), "+v"(a0) :: "memory");
        BIG_ROW(0, a0)
        asm volatile("s_waitcnt lgkmcnt(6)" : "+v"(a1) :: "memory");
        BIG_ROW(1, a1)
        asm volatile("s_waitcnt lgkmcnt(5)" : "+v"(a2) :: "memory");
        BIG_ROW(2, a2)
        asm volatile("s_waitcnt lgkmcnt(4)" : "+v"(a3) :: "memory");
        BIG_ROW(3, a3)
        asm volatile("s_waitcnt lgkmcnt(3)" : "+v"(a4) :: "memory");
        BIG_ROW(4, a4)
        asm volatile("s_waitcnt lgkmcnt(2)" : "+v"(a5) :: "memory");
        BIG_ROW(5, a5)
        asm volatile("s_waitcnt lgkmcnt(1)" : "+v"(a6) :: "memory");
        BIG_ROW(6, a6)
        asm volatile("s_waitcnt lgkmcnt(0)" : "+v"(a7) :: "memory");
        BIG_ROW(7, a7)
#undef BIG_ROW
        stage = (stage == 2) ? 0 : stage + 1;
    }
#undef BIG_ISSUE
    __syncthreads();
}
template <int TM, int TN, int WM, int WN, bool XT = false>
__device__ __forceinline__ void gemm_any(f32x4 (&acc)[TM][TN], const u16* __restrict__ Wmat, const int n0, const int ldw,
                                         const u16* __restrict__ X, const int ldx, const int K, unsigned char* lds) {
    if constexpr (TM == 8) gemm_big<XT>(acc, Wmat + (size_t)n0 * ldw, ldw, X, ldx, K, lds);
    else gemm_accum<TM, TN, WM, WN, true, XT>(acc, Wmat, ldw, X, ldx, K, (u16*)lds, n0);
}

#define ACC_ZERO(a) { _Pragma("unroll") for (int i_ = 0; i_ < TM; ++i_) { _Pragma("unroll") for (int j_ = 0; j_ < TN; ++j_) a[i_][j_] = (f32x4){0.f, 0.f, 0.f, 0.f}; } }
#define TILE_IDS const int tid = otid(), lane = tid & 63, wid = tid >> 6, wm = wid / WN, wn = wid % WN, fr = lane & 15, fq = lane >> 4; (void)tid; (void)wm; (void)wn;

struct TrJob { const float* src; u16* dst; int K, N, k0, n0, tiled; };
__device__ __forceinline__ TrJob tr_job(const Params& P, int id) {
    TrJob j; int t; j.tiled = 1;
    if (id < 3456) { const int l = id / 1728; t = id % 1728; j.K = 1024; j.N = NIN; j.src = P.in[6] + (size_t)l * 1024 * NIN; j.dst = (u16*)(P.ws + WS_WIN) + (size_t)l * NIN * 1024; }
    else if (id < 4224) { const int m = (id - 3456) / 128; t = (id - 3456) % 128; j.K = 512; j.N = 1024; j.src = P.in[22] + (size_t)m * 512 * 1024; j.dst = (u16*)(P.ws + WS_WR) + (size_t)m * 1024 * 512; }
    else if (id < 4736) { const int l = (id - 4224) / 256; t = (id - 4224) % 256; j.K = 1024; j.N = 1024; j.src = P.in[23] + (size_t)l * 1024 * 1024; j.dst = (u16*)(P.ws + WS_WO) + (size_t)l * 1024 * 1024; }
    else { const int l = (id - 4736) / 64; t = (id - 4736) % 64; j.tiled = 0; j.K = 512; j.N = 512; j.src = P.in[16] + (size_t)l * 512 * 512; j.dst = (u16*)(P.ws + WS_GLU) + (size_t)l * 512 * 512; }
    const int ntn = j.N / 64; j.k0 = (t / ntn) * 64; j.n0 = (t % ntn) * 64;
    return j;
}

__device__ void phase0(const Params& P, unsigned char* smem) {
    float* tl = (float*)smem;
    u16* ws16;
    const int tid = otid();
    {
        const int n = tid & 63, kk = tid >> 6, k2 = (tid & 31) * 2, nn = tid >> 5;
        float r[16];
        int id = blockIdx.x;
        TrJob j;
        if (id < 4864) { j = tr_job(P, id);
#pragma unroll
            for (int i = 0; i < 16; ++i) r[i] = __builtin_nontemporal_load(&j.src[(size_t)(j.k0 + kk + 4 * i) * j.N + j.n0 + n]); }
        while (id < 4864) {
#pragma unroll
            for (int i = 0; i < 16; ++i) tl[(kk + 4 * i) * 65 + n] = r[i];
            __syncthreads();
            const int idn = id + gridDim.x;
            TrJob jn = j;
            if (idn < 4864) { jn = tr_job(P, idn);
#pragma unroll
                for (int i = 0; i < 16; ++i) r[i] = __builtin_nontemporal_load(&jn.src[(size_t)(jn.k0 + kk + 4 * i) * jn.N + jn.n0 + n]); }
#pragma unroll
            for (int i = 0; i < 8; ++i) { const int nr = nn + 8 * i; const size_t o = j.tiled ? wt_ofs(j.n0 + nr, j.k0 + k2, j.K) : ((size_t)(j.n0 + nr) * j.K + j.k0 + k2);
                *(unsigned*)(j.dst + o) = cvt_pk_bf16(tl[k2 * 65 + nr], tl[(k2 + 1) * 65 + nr]); }
            __syncthreads();
            j = jn; id = idn;
        }
    }
    const int gtid = blockIdx.x * 256 + tid, gsz = gridDim.x * 256;
    ws16 = (u16*)(P.ws + WS_XBF);
    for (int i0 = gtid; i0 < TT * 128; i0 += 4 * gsz) {
        float4 a[4], b[4];
#pragma unroll
        for (int u = 0; u < 4; ++u) {
            const int i = i0 + u * gsz;
            if (i < TT * 128) {
                const int r = i >> 7, c = (i & 127) * 8;
                const float* sp = (r < TP) ? (P.in[0] + (size_t)r * 1024 + c) : (P.in[1] + (size_t)(r - TP) * 1024 + c);
                { const f32x4 t0 = __builtin_nontemporal_load((const f32x4*)sp), t1 = __builtin_nontemporal_load((const f32x4*)(sp + 4));
                  a[u] = make_float4(t0[0], t0[1], t0[2], t0[3]); b[u] = make_float4(t1[0], t1[1], t1[2], t1[3]); }
            }
        }
#pragma unroll
        for (int u = 0; u < 4; ++u) {
            const int i = i0 + u * gsz;
            if (i < TT * 128) {
                const int r = i >> 7, c = (i & 127) * 8;
                uint4 w; w.x = cvt_pk_bf16(a[u].x, a[u].y); w.y = cvt_pk_bf16(a[u].z, a[u].w); w.z = cvt_pk_bf16(b[u].x, b[u].y); w.w = cvt_pk_bf16(b[u].z, b[u].w);
                *(uint4*)(ws16 + xt_ofs(r, c)) = w;
            }
        }
    }
    ws16 = (u16*)(P.ws + WS_SGUW);
    for (int i = gtid; i < 2 * 4 * 128 * 128; i += gsz) {
        const int s_ = i & 127, t = (i >> 7) & 127;
        ws16[i] = (s_ <= t) ? f2bf(P.in[20][i]) : (u16)0;
    }
    for (int t = gtid; t < 65536; t += gsz) {
        const int i = t >> 4, h = t & 15;
        const int p = i & 63, g = (i >> 6) & 31, l = i >> 11;
        const float lr = P.in[8][i], li = P.in[9][i], dt = expf(P.in[10][l * 32 + g]);
        const float br = P.in[11][t], bi = P.in[12][t];
        const float cre = P.in[13][((size_t)(l * 32 + g) * 16 + h) * 64 + p], cim = P.in[14][((size_t)(l * 32 + g) * 16 + h) * 64 + p];
        const float mag = expf(lr * dt), ang = li * dt;
        const float ar = mag * cosf(ang), ai = mag * sinf(ang);
        const float den = lr * lr + li * li;
        const float cr = ((ar - 1.0f) * lr + ai * li) / den, ci = (ai * lr - (ar - 1.0f) * li) / den;
        if (h == 0) {
            float* abar = (float*)(P.ws + WS_ABAR); abar[2 * i] = ar; abar[2 * i + 1] = ai;
            float pr = ar, pi = ai;
#pragma unroll
            for (int k = 0; k < 7; ++k) { const float nr = pr * pr - pi * pi, ni = 2.0f * pr * pi; pr = nr; pi = ni; }
            float* a128 = (float*)(P.ws + WS_A128); a128[2 * i] = pr; a128[2 * i + 1] = pi;
        }
        u16* bbt = (u16*)(P.ws + WS_BBT) + (size_t)(l * 32 + g) * 128 * 16;
        bbt[p * 16 + h] = f2bf(cr * br - ci * bi);
        bbt[(64 + p) * 16 + h] = f2bf(cr * bi + ci * br);
        u16* cmt = (u16*)(P.ws + WS_CMT) + (size_t)(l * 32 + g) * 16 * 128;
        cmt[h * 128 + p] = f2bf(cre);
        cmt[h * 128 + 64 + p] = f2bf(-cim);
    }
}

#define XCD_TILE_LOOP(q, NT) for (int S_ = (int)gridDim.x >> 3, ch_ = (int)blockIdx.x & 7, q = ch_ * S_ + ((int)blockIdx.x >> 3); ch_ * S_ < (NT); ch_ += 8, q = ch_ * S_ + ((int)blockIdx.x >> 3)) if (q < (NT))

__device__ void phase1(const Params& P, int l, unsigned char* smem) {
    constexpr int TM = 8, TN = 4, WM = 2, WN = 2;
    TILE_IDS
    u16* proj = (u16*)(P.ws + WS_PROJ);
    const u16* xbf = (const u16*)(P.ws + WS_XBF);
    const u16* win = (const u16*)(P.ws + WS_WIN) + (size_t)l * NIN * 1024;
    u16* vT = (u16*)(P.ws + WS_VT);
    XCD_TILE_LOOP(id, 129 * 15) {
        const int pnl = id / 645, q5 = id % 645, tm = q5 / 5, tn = pnl * 5 + q5 % 5;
        const int tok0 = tm * 128, col0 = tn * 256;
        f32x4 acc[TM][TN];
        ACC_ZERO(acc)
        gemm_big<true>(acc, win + (size_t)col0 * 1024, 1024, xbf + (size_t)tok0 * 1024, 1024, 1024, smem);
        const bool kvrow = (tm == 63 || tm == 127 || tm == 128);
#pragma unroll
        for (int i = 0; i < TM; ++i)
#pragma unroll
            for (int j = 0; j < TN; ++j) {
                const int tok = tok0 + (wn * TN + j) * 16 + fr, col = col0 + (wm * TM + i) * 16 + 4 * fq;
                const f32x4 a = acc[i][j];
                store_bf4(proj + (size_t)tok * NPROJ + col, a[0], a[1], a[2], a[3]);
                if (tn == 2) {
                    const bool isk = col < OV;
                    const int cc = col - (isk ? OKK : OV);
                    if (kvrow) {
                        float* o;
                        if (tm == 128) o = P.out + (isk ? O_KS : O_VS) + ((size_t)l * 128 + (tok - TP)) * 128 + cc;
                        else o = P.out + (isk ? O_KP : O_VP) + (((size_t)l * 2 + (tm == 127 ? 1 : 0)) * 128 + (tok - tok0)) * 128 + cc;
                        *(f32x4*)o = a;
                    }
                    if (!isk && tm < 128) {
                        const int kvh = cc >> 6, d = cc & 63, n = tok >> 13, pos = tok & 8191;
                        u16* vp = vT + ((size_t)((n * 2 + kvh) * 64 + d)) * 8192 + pos;
#pragma unroll
                        for (int r = 0; r < 4; ++r) vp[(size_t)r * 8192] = f2bf(a[r]);
                    }
                }
            }
    }
}

#define ATT_DEAD(kt, nt) (((nt) == 0 && (kt) == 9) || ((nt) == 1 && (kt) == 0))
__device__ void attn_item(const Params& P, int l, int item, unsigned char* smem) {
    const int tid = otid(), lane = tid & 63, wid = tid >> 6, fr = lane & 15, fq = lane >> 4;
    const int xcd_ = item & 7, s_ = (item >> 3) & 63, n = item >> 9;
    const int blk = xcd_ * 8 + (s_ >> 3), h = s_ & 7, kvh = h >> 2;
    u16* proj = (u16*)(P.ws + WS_PROJ);
    const u16* vT = (const u16*)(P.ws + WS_VT);
    u16* Ks = (u16*)smem;
    u16* VT = Ks + 256 * 72;
    const int kpos0 = (blk - 1) * 128;
    {
        uint4 kr[8], vr[8];
#pragma unroll
        for (int k = 0; k < 8; ++k) {
            const int i = tid + 256 * k;
            const int key = i >> 3, c8 = i & 7, pos = kpos0 + key, posc = pos < 0 ? 0 : pos;
            kr[k] = *(const uint4*)(proj + (size_t)(n * SEQL + posc) * NPROJ + OKK + kvh * 64 + c8 * 8);
            const int d = i >> 5, c = i & 31, vpos = kpos0 + c * 8, vposc = vpos < 0 ? 0 : vpos;
            vr[k] = *(const uint4*)(vT + ((size_t)((n * 2 + kvh) * 64 + d)) * 8192 + vposc);
        }
#pragma unroll
        for (int k = 0; k < 8; ++k) {
            const int i = tid + 256 * k;
            const int key = i >> 3, c8 = i & 7, pos = kpos0 + key;
            *(uint4*)(Ks + key * 72 + c8 * 8) = (pos >= 0) ? kr[k] : make_uint4(0, 0, 0, 0);
            const int d = i >> 5, c = i & 31, vpos = kpos0 + c * 8;
            *(uint4*)(VT + d * 264 + c * 8) = (vpos >= 0) ? vr[k] : make_uint4(0, 0, 0, 0);
        }
    }
    const int q0 = blk * 128 + wid * 32;
    const float slope = exp2f(-(float)(h + 1)), sink = P.in[7][l * 8 + h];
    bf16x8 qfa[2][2];
    uint2 zza[2][4];
#pragma unroll
    for (int nt = 0; nt < 2; ++nt) {
        const u16* rp = proj + (size_t)(n * SEQL + q0 + nt * 16 + fr) * NPROJ;
#pragma unroll
        for (int ks = 0; ks < 2; ++ks) qfa[nt][ks] = *(const bf16x8*)(rp + OQ + h * 64 + ks * 32 + fq * 8);
#pragma unroll
        for (int dt = 0; dt < 4; ++dt) zza[nt][dt] = *(const uint2*)(rp + OZA + h * 64 + dt * 16 + 4 * fq);
    }
    __syncthreads();
#pragma unroll
    for (int nt = 0; nt < 2; ++nt) {
        u16* rowp = proj + (size_t)(n * SEQL + q0 + nt * 16 + fr) * NPROJ;
        bf16x8 qf[2];
#pragma unroll
        for (int ks = 0; ks < 2; ++ks) qf[ks] = qfa[nt][ks];
        f32x4 st[10];
#pragma unroll
        for (int kt = 0; kt < 10; ++kt) {
            st[kt] = (f32x4){0.f, 0.f, 0.f, 0.f};
            if (ATT_DEAD(kt, nt)) continue;
#pragma unroll
            for (int ks = 0; ks < 2; ++ks) {
                const bf16x8 kf = *(const bf16x8*)(Ks + (wid * 32 + kt * 16 + fr) * 72 + ks * 32 + fq * 8);
                st[kt] = mfma32(kf, qf[ks], st[kt]);
            }
        }
        const int qi = wid * 32 + nt * 16 + fr;
        float mx = sink;
#pragma unroll
        for (int kt = 0; kt < 10; ++kt) {
            if (ATT_DEAD(kt, nt)) continue;
#pragma unroll
            for (int r = 0; r < 4; ++r) {
                const int kk = wid * 32 + kt * 16 + 4 * fq + r, dist = 128 + qi - kk;
                const bool inner = (kt - nt >= 1) && (kt - nt <= 7);
                const bool valid = (inner || ((dist >= 0) && (dist <= 128))) && (blk > 0 || kk >= 128);
                const float s = valid ? (st[kt][r] * 0.125f - slope * (float)dist) : -1e30f;
                st[kt][r] = s; mx = fmaxf(mx, s);
            }
        }
        mx = fmaxf(mx, __shfl_xor(mx, 16)); mx = fmaxf(mx, __shfl_xor(mx, 32));
        float sum = 0.f;
#pragma unroll
        for (int kt = 0; kt < 10; ++kt) {
            if (ATT_DEAD(kt, nt)) continue;
#pragma unroll
            for (int r = 0; r < 4; ++r) { const float p = __expf(st[kt][r] - mx); st[kt][r] = p; sum += p; }
        }
        sum += __shfl_xor(sum, 16); sum += __shfl_xor(sum, 32);
        const float inv = 1.0f / (sum + __expf(sink - mx));
        f32x4 o[4];
#pragma unroll
        for (int dt = 0; dt < 4; ++dt) o[dt] = (f32x4){0.f, 0.f, 0.f, 0.f};
#pragma unroll
        for (int kt = 0; kt < 10; ++kt) {
            if (ATT_DEAD(kt, nt)) continue;
            const unsigned w0 = cvt_pk_bf16(st[kt][0] * inv, st[kt][1] * inv), w1 = cvt_pk_bf16(st[kt][2] * inv, st[kt][3] * inv);
            const bf16x4 pf = (bf16x4){(short)(w0 & 0xffff), (short)(w0 >> 16), (short)(w1 & 0xffff), (short)(w1 >> 16)};
#pragma unroll
            for (int dt = 0; dt < 4; ++dt) {
                const bf16x4 vf = *(const bf16x4*)(VT + (dt * 16 + fr) * 264 + wid * 32 + kt * 16 + 4 * fq);
                o[dt] = mfma16(vf, pf, o[dt]);
            }
        }
        uint2 zz[4];
#pragma unroll
        for (int dt = 0; dt < 4; ++dt) zz[dt] = zza[nt][dt];
#pragma unroll
        for (int dt = 0; dt < 4; ++dt) {
            const int d = h * 64 + dt * 16 + 4 * fq;
            const uint2 z = zz[dt];
            store_bf4(rowp + OQ + d, o[dt][0] * siluf_(bflo(z.x)), o[dt][1] * siluf_(bfhi(z.x)),
                      o[dt][2] * siluf_(bflo(z.y)), o[dt][3] * siluf_(bfhi(z.y)));
        }
    }
    __syncthreads();
}

#undef ATT_DEAD
__device__ void sgu_item(const Params& P, int l, int item, unsigned char* smem) {
    const int tid = otid(), lane = tid & 63, wid = tid >> 6, fr = lane & 15, fq = lane >> 4;
    const int g = (item >> 3) & 3, c = (item & 7) * 16 + (item >> 5);
    u16* proj = (u16*)(P.ws + WS_PROJ);
    const u16* sguw = (const u16*)(P.ws + WS_SGUW);
    u16* VnT = (u16*)smem;
    float* stat = (float*)(smem + 128 * 136 * 2);
    const size_t row0 = (size_t)c * 128;
    bf16x8 wfa[4][2];
#pragma unroll
    for (int ks = 0; ks < 4; ++ks)
#pragma unroll
        for (int tt = 0; tt < 2; ++tt) wfa[ks][tt] = *(const bf16x8*)(sguw + ((size_t)((l * 4 + g) * 128 + wid * 32 + tt * 16 + fr)) * 128 + ks * 32 + fq * 8);
    {
        const int q4 = lane >> 4, r16 = lane & 15;
#pragma unroll 1
        for (int ps = 0; ps < 8; ps += 4) {
            uint4 raw[4][4];
#pragma unroll
            for (int pp = 0; pp < 4; ++pp) {
                const int s_ = wid * 32 + (ps + pp) * 4 + q4;
#pragma unroll
                for (int c = 0; c < 4; ++c) raw[pp][c] = *(const uint4*)(proj + (row0 + s_) * NPROJ + OVC + r16 * 32 + c * 8);
            }
#pragma unroll
            for (int pp = 0; pp < 4; ++pp) {
                const int s_ = wid * 32 + (ps + pp) * 4 + q4;
                float sum = 0.f, sq = 0.f;
#pragma unroll
                for (int c = 0; c < 4; ++c) {
                    const uint4 w = raw[pp][c];
                    const float v[8] = {bflo(w.x), bfhi(w.x), bflo(w.y), bfhi(w.y), bflo(w.z), bfhi(w.z), bflo(w.w), bfhi(w.w)};
#pragma unroll
                    for (int e = 0; e < 8; ++e) { sum += v[e]; sq += v[e] * v[e]; }
                }
#pragma unroll
                for (int o = 1; o < 16; o <<= 1) { sum += __shfl_xor(sum, o); sq += __shfl_xor(sq, o); }
                const float mean = sum * (1.0f / 512.0f);
                const float var = fmaxf(sq * (1.0f / 512.0f) - mean * mean, 0.f);
                if (r16 == 0) { stat[2 * s_] = mean; stat[2 * s_ + 1] = rsqrtf(var + 1e-5f); }
            }
        }
    }
    __syncthreads();
    {
        const int s = tid & 127, half = tid >> 7;
        const float mean = stat[2 * s], rstd = stat[2 * s + 1];
        const u16* src = proj + (row0 + s) * NPROJ + OVC + g * 128 + half * 64;
        const float* lng = P.in[18] + l * 512 + g * 128 + half * 64;
        const float* lnb = P.in[19] + l * 512 + g * 128 + half * 64;
#pragma unroll
        for (int c8 = 0; c8 < 8; ++c8) {
            const uint4 raw = *(const uint4*)(src + c8 * 8);
            const float v[8] = {bflo(raw.x), bfhi(raw.x), bflo(raw.y), bfhi(raw.y), bflo(raw.z), bfhi(raw.z), bflo(raw.w), bfhi(raw.w)};
            const float4 g0 = *(const float4*)(lng + c8 * 8), g1 = *(const float4*)(lng + c8 * 8 + 4), b0 = *(const float4*)(lnb + c8 * 8), b1 = *(const float4*)(lnb + c8 * 8 + 4);
            const float gg[8] = {g0.x, g0.y, g0.z, g0.w, g1.x, g1.y, g1.z, g1.w}, bb[8] = {b0.x, b0.y, b0.z, b0.w, b1.x, b1.y, b1.z, b1.w};
#pragma unroll
            for (int e = 0; e < 8; ++e) {
                const int w = c8 * 8 + e;
                VnT[(half * 64 + w) * 136 + s] = f2bf((v[e] - mean) * rstd * gg[e] + bb[e]);
            }
        }
    }
    __syncthreads();
    f32x4 acc[8][2];
#pragma unroll
    for (int wt = 0; wt < 8; ++wt) { acc[wt][0] = (f32x4){0.f, 0.f, 0.f, 0.f}; acc[wt][1] = (f32x4){0.f, 0.f, 0.f, 0.f}; }
    uint2 uu[2][8], zz[2][8];
    float biasv[2];
#pragma unroll
    for (int tt = 0; tt < 2; ++tt) {
        const int t = wid * 32 + tt * 16 + fr;
        biasv[tt] = P.in[21][(l * 4 + g) * 128 + t];
        const u16* rowp = proj + (row0 + t) * NPROJ;
#pragma unroll
        for (int wt = 0; wt < 8; ++wt) { const int w = g * 128 + wt * 16 + 4 * fq; uu[tt][wt] = *(const uint2*)(rowp + OUC + w); zz[tt][wt] = *(const uint2*)(rowp + OZC + w); }
    }
#pragma unroll
    for (int ks = 0; ks < 4; ++ks) {
        if (ks <= wid) {
#pragma unroll
            for (int wt = 0; wt < 8; ++wt) {
                const bf16x8 vf = *(const bf16x8*)(VnT + (wt * 16 + fr) * 136 + ks * 32 + fq * 8);
                acc[wt][0] = mfma32(vf, wfa[ks][0], acc[wt][0]);
                acc[wt][1] = mfma32(vf, wfa[ks][1], acc[wt][1]);
            }
        }
    }
#pragma unroll
    for (int tt = 0; tt < 2; ++tt) {
        const int t = wid * 32 + tt * 16 + fr;
        const float bias = biasv[tt];
        u16* rowp = proj + (row0 + t) * NPROJ;
#pragma unroll
        for (int wt = 0; wt < 8; ++wt) {
            const int w = g * 128 + wt * 16 + 4 * fq;
            const uint2 u = uu[tt][wt], z = zz[tt][wt];
            const f32x4 a = acc[wt][tt];
            store_bf4(rowp + OUC + w, bflo(u.x) * (a[0] + bias) * siluf_(bflo(z.x)), bfhi(u.x) * (a[1] + bias) * siluf_(bfhi(z.x)),
                      bflo(u.y) * (a[2] + bias) * siluf_(bflo(z.y)), bfhi(u.y) * (a[3] + bias) * siluf_(bfhi(z.y)));
        }
    }
    __syncthreads();
}

template <bool FULL>
__device__ void s5_item(const Params& P, int l, int item, unsigned char* smem) {
    const int tid = otid(), lane = tid & 63, wid = tid >> 6, fr = lane & 15, fq = lane >> 4;
    const int tau = item * 4 + wid, g = tau & 31, c = tau >> 5;
    float* xs = (float*)smem + wid * (16 * 132);
    u16* hs = (u16*)(smem + 4 * 16 * 132 * 4) + wid * (16 * 136);
    u16* proj = (u16*)(P.ws + WS_PROJ);
    const float* abar = (const float*)(P.ws + WS_ABAR) + (size_t)((l * 32 + g) * 64 + lane) * 2;
    const float ar = abar[0], ai = abar[1];
    const u16* bbt = (const u16*)(P.ws + WS_BBT) + (size_t)(l * 32 + g) * 128 * 16;
    bf16x4 bfrag[8];
#pragma unroll
    for (int nt = 0; nt < 8; ++nt) bfrag[nt] = *(const bf16x4*)(bbt + (nt * 16 + fr) * 16 + 4 * fq);
    bf16x8 cfrag[4];
    float dsk[4];
    if (FULL) {
        const u16* cmt = (const u16*)(P.ws + WS_CMT) + (size_t)(l * 32 + g) * 16 * 128;
#pragma unroll
        for (int ks = 0; ks < 4; ++ks) cfrag[ks] = *(const bf16x8*)(cmt + fr * 128 + ks * 32 + fq * 8);
#pragma unroll
        for (int r = 0; r < 4; ++r) dsk[r] = P.in[15][l * 512 + g * 16 + 4 * fq + r];
    }
    float* sst = (float*)(P.ws + WS_SST);
    float hr = 0.f, hi = 0.f;
    if (FULL) {
        const int cl = c & 63;
        const float* a128 = (const float*)(P.ws + WS_A128) + (size_t)((l * 32 + g) * 64 + lane) * 2;
        const float Ar = a128[0], Ai = a128[1];
        const float* S = sst + ((size_t)(c - cl) * 32 + g) * 128;
        int j = 0;
        for (; j + 32 <= cl; j += 32) {
            float sr[32], si[32];
#pragma unroll
            for (int k = 0; k < 32; ++k) { sr[k] = S[(size_t)(j + k) * 4096 + lane]; si[k] = S[(size_t)(j + k) * 4096 + 64 + lane]; }
#pragma unroll
            for (int k = 0; k < 32; ++k) { const float nr = Ar * hr - Ai * hi + sr[k]; hi = Ar * hi + Ai * hr + si[k]; hr = nr; }
        }
        for (; j + 8 <= cl; j += 8) {
            float sr[8], si[8];
#pragma unroll
            for (int k = 0; k < 8; ++k) { sr[k] = S[(size_t)(j + k) * 4096 + lane]; si[k] = S[(size_t)(j + k) * 4096 + 64 + lane]; }
#pragma unroll
            for (int k = 0; k < 8; ++k) { const float nr = Ar * hr - Ai * hi + sr[k]; hi = Ar * hi + Ai * hr + si[k]; hr = nr; }
        }
        for (; j < cl; ++j) {
            const float sr = S[(size_t)j * 4096 + lane], si = S[(size_t)j * 4096 + 64 + lane];
            const float nr = Ar * hr - Ai * hi + sr; hi = Ar * hi + Ai * hr + si; hr = nr;
        }
    }
    u16* ub = proj + (size_t)(c * 128) * NPROJ + OUB + g * 16 + 4 * fq;
    bf16x4 ufs[8];
#pragma unroll
    for (int sc = 0; sc < 8; ++sc) ufs[sc] = *(const bf16x4*)(ub + (size_t)(sc * 16 + fr) * NPROJ);
#pragma unroll
    for (int sc = 0; sc < 8; ++sc) {
        u16* up = ub + (size_t)(sc * 16 + fr) * NPROJ;
        const bf16x4 uf = ufs[sc];
#pragma unroll
        for (int nt = 0; nt < 8; ++nt) {
            const f32x4 x = mfma16(uf, bfrag[nt], (f32x4){0.f, 0.f, 0.f, 0.f});
#pragma unroll
            for (int r = 0; r < 4; ++r) xs[(4 * fq + r) * 132 + nt * 16 + fr] = x[r];
        }
        __syncthreads();
        float xrv[16], xiv[16];
#pragma unroll
        for (int t = 0; t < 16; ++t) { xrv[t] = xs[t * 132 + lane]; xiv[t] = xs[t * 132 + 64 + lane]; }
#pragma unroll
        for (int t = 0; t < 16; ++t) {
            const float xr = xrv[t], xi = xiv[t];
            const float nr = ar * hr - ai * hi + xr; hi = ar * hi + ai * hr + xi; hr = nr;
            if (FULL) { hs[t * 136 + lane] = f2bf(hr); hs[t * 136 + 64 + lane] = f2bf(hi); }
        }
        __syncthreads();
        if (FULL) {
            f32x4 y = (f32x4){0.f, 0.f, 0.f, 0.f};
#pragma unroll
            for (int ks = 0; ks < 4; ++ks) {
                const bf16x8 hf = *(const bf16x8*)(hs + fr * 136 + ks * 32 + fq * 8);
                y = mfma32(cfrag[ks], hf, y);
            }
            float o[4];
#pragma unroll
            for (int r = 0; r < 4; ++r) o[r] = geluf_(y[r] + dsk[r] * bf2f((u16)uf[r]));
            store_bf4(up, o[0], o[1], o[2], o[3]);
        }
    }
    if (!FULL) { float* S = sst + ((size_t)c * 32 + g) * 128; S[lane] = hr; S[64 + lane] = hi; }
    else if ((c & 63) == 63) {
        const size_t o = ((size_t)(l * 2 + (c >> 6)) * 32 + g) * 64 + lane;
        P.out[O_HRP + o] = hr; P.out[O_HIP + o] = hi;
    }
    __syncthreads();
}

__device__ void sample_item(const Params& P, int l, int b, int part, unsigned char* smem) {
    const int tid = otid(), lane = tid & 63, wid = tid >> 6;
    u16* prow = (u16*)(P.ws + WS_PROJ) + (size_t)(TP + b) * NPROJ;
    float* row = (float*)smem;
    float* sc = row + 3840;
    float* red = sc + 8 * 132;
    float* hst = red + 64;
    if (part == 0) {
        if (tid < 160) {
            const uint4 raw = *(const uint4*)(prow + tid * 8);
            float* r = row + tid * 8;
            r[0] = bflo(raw.x); r[1] = bfhi(raw.x); r[2] = bflo(raw.y); r[3] = bfhi(raw.y); r[4] = bflo(raw.z); r[5] = bfhi(raw.z); r[6] = bflo(raw.w); r[7] = bfhi(raw.w);
        }
        __syncthreads();
        {
            const int j = tid & 127, kvh = tid >> 7;
            const float* ck = P.in[2] + (((size_t)l * 128 + b) * 128 + j) * 128 + kvh * 64;
            float4 kk[16];
#pragma unroll
            for (int d = 0; d < 16; ++d) { const f32x4 t_ = __builtin_nontemporal_load((const f32x4*)(ck + 4 * d)); kk[d] = make_float4(t_[0], t_[1], t_[2], t_[3]); }
            const float* q = row + OQ + kvh * 256;
            float d0 = 0.f, d1 = 0.f, d2 = 0.f, d3 = 0.f;
#pragma unroll
            for (int d4 = 0; d4 < 16; ++d4) {
                const int d = 4 * d4; const float4 k4 = kk[d4];
                d0 += q[d] * k4.x + q[d + 1] * k4.y + q[d + 2] * k4.z + q[d + 3] * k4.w;
                d1 += q[64 + d] * k4.x + q[64 + d + 1] * k4.y + q[64 + d + 2] * k4.z + q[64 + d + 3] * k4.w;
                d2 += q[128 + d] * k4.x + q[128 + d + 1] * k4.y + q[128 + d + 2] * k4.z + q[128 + d + 3] * k4.w;
                d3 += q[192 + d] * k4.x + q[192 + d + 1] * k4.y + q[192 + d + 2] * k4.z + q[192 + d + 3] * k4.w;
            }
            const float dist = (float)(128 - j);
            const int h0 = kvh * 4;
            sc[(h0 + 0) * 132 + j] = d0 * 0.125f - exp2f(-(float)(h0 + 1)) * dist;
            sc[(h0 + 1) * 132 + j] = d1 * 0.125f - exp2f(-(float)(h0 + 2)) * dist;
            sc[(h0 + 2) * 132 + j] = d2 * 0.125f - exp2f(-(float)(h0 + 3)) * dist;
            sc[(h0 + 3) * 132 + j] = d3 * 0.125f - exp2f(-(float)(h0 + 4)) * dist;
            if (tid < 8) {
                const int h = tid;
                const float* qq = row + OQ + h * 64; const float* k2 = row + OKK + (h >> 2) * 64;
                float d = 0.f;
                for (int e = 0; e < 64; ++e) d += qq[e] * k2[e];
                sc[h * 132 + 128] = d * 0.125f;
            }
        }
        __syncthreads();
#pragma unroll
        for (int hh = 0; hh < 2; ++hh) {
            const int h = wid * 2 + hh;
            const float sink = P.in[7][l * 8 + h];
            const float s0 = sc[h * 132 + lane], s1 = sc[h * 132 + 64 + lane], s2 = (lane == 0) ? sc[h * 132 + 128] : -1e30f;
            const float mx = fmaxf(wave_max(fmaxf(fmaxf(s0, s1), s2)), sink);
            const float e0 = __expf(s0 - mx), e1 = __expf(s1 - mx), e2 = (lane == 0) ? __expf(s2 - mx) : 0.f;
            const float inv = 1.0f / (wave_sum(e0 + e1 + e2) + __expf(sink - mx));
            sc[h * 132 + lane] = e0 * inv; sc[h * 132 + 64 + lane] = e1 * inv;
            if (lane == 0) sc[h * 132 + 128] = e2 * inv;
        }
        __syncthreads();
        {
            const int d = tid & 63, jq = (tid >> 6) & 1, kvh = tid >> 7;
            const float* cv = P.in[3] + (((size_t)l * 128 + b) * 128 + jq * 64) * 128 + kvh * 64 + d;
            const float* p = sc + (kvh * 4) * 132 + jq * 64;
            float a0 = 0.f, a1 = 0.f, a2 = 0.f, a3 = 0.f;
#pragma unroll
            for (int jb = 0; jb < 64; jb += 32) {
                float vv[32];
#pragma unroll
                for (int j = 0; j < 32; ++j) vv[j] = __builtin_nontemporal_load(&cv[(size_t)(jb + j) * 128]);
#pragma unroll
                for (int j = 0; j < 32; ++j) { a0 += p[jb + j] * vv[j]; a1 += p[132 + jb + j] * vv[j]; a2 += p[264 + jb + j] * vv[j]; a3 += p[396 + jb + j] * vv[j]; }
            }
            float* pp = hst + ((kvh * 2 + jq) * 4) * 64 + d;
            pp[0] = a0; pp[64] = a1; pp[128] = a2; pp[192] = a3;
        }
        __syncthreads();
#pragma unroll
        for (int rep = 0; rep < 2; ++rep) {
            const int idx = tid + rep * 256, h = idx >> 6, d = idx & 63, kvh = h >> 2, hh = h & 3;
            const float acc = hst[((kvh * 2 + 0) * 4 + hh) * 64 + d] + hst[((kvh * 2 + 1) * 4 + hh) * 64 + d] + sc[h * 132 + 128] * row[OV + kvh * 64 + d];
            prow[OQ + idx] = f2bf(acc * siluf_(row[OZA + idx]));
        }
    } else {
        {
            const int c = (tid < 64) ? (OUB + tid * 8) : (OUC + (tid - 64) * 8);
            const uint4 raw = *(const uint4*)(prow + c);
            float* r = row + c;
            r[0] = bflo(raw.x); r[1] = bfhi(raw.x); r[2] = bflo(raw.y); r[3] = bfhi(raw.y); r[4] = bflo(raw.z); r[5] = bfhi(raw.z); r[6] = bflo(raw.w); r[7] = bfhi(raw.w);
        }
        __syncthreads();
        {
            const int p = lane;
            const float* abar = (const float*)(P.ws + WS_ABAR);
#pragma unroll
            for (int gi = 0; gi < 8; ++gi) {
                const int g = wid + 4 * gi;
                const u16* bb = (const u16*)(P.ws + WS_BBT) + (size_t)(l * 32 + g) * 128 * 16;
                const uint4 r0 = *(const uint4*)(bb + p * 16), r1 = *(const uint4*)(bb + p * 16 + 8);
                const uint4 i0 = *(const uint4*)(bb + (64 + p) * 16), i1 = *(const uint4*)(bb + (64 + p) * 16 + 8);
                const float* u = row + OUB + g * 16;
                const float xr = bflo(r0.x) * u[0] + bfhi(r0.x) * u[1] + bflo(r0.y) * u[2] + bfhi(r0.y) * u[3] + bflo(r0.z) * u[4] + bfhi(r0.z) * u[5] + bflo(r0.w) * u[6] + bfhi(r0.w) * u[7]
                               + bflo(r1.x) * u[8] + bfhi(r1.x) * u[9] + bflo(r1.y) * u[10] + bfhi(r1.y) * u[11] + bflo(r1.z) * u[12] + bfhi(r1.z) * u[13] + bflo(r1.w) * u[14] + bfhi(r1.w) * u[15];
                const float xi = bflo(i0.x) * u[0] + bfhi(i0.x) * u[1] + bflo(i0.y) * u[2] + bfhi(i0.y) * u[3] + bflo(i0.z) * u[4] + bfhi(i0.z) * u[5] + bflo(i0.w) * u[6] + bfhi(i0.w) * u[7]
                               + bflo(i1.x) * u[8] + bfhi(i1.x) * u[9] + bflo(i1.y) * u[10] + bfhi(i1.y) * u[11] + bflo(i1.z) * u[12] + bfhi(i1.z) * u[13] + bflo(i1.w) * u[14] + bfhi(i1.w) * u[15];
                const size_t si = (((size_t)l * 128 + b) * 32 + g) * 64 + p;
                const float h0r = P.in[4][si], h0i = P.in[5][si];
                const float ar = abar[((l * 32 + g) * 64 + p) * 2], ai = abar[((l * 32 + g) * 64 + p) * 2 + 1];
                const float hr = ar * h0r - ai * h0i + xr, hi = ar * h0i + ai * h0r + xi;
                P.out[O_HRS + si] = hr; P.out[O_HIS + si] = hi;
                hst[g * 128 + p] = hr; hst[g * 128 + 64 + p] = hi;
            }
        }
        __syncthreads();
#pragma unroll
        for (int rep = 0; rep < 2; ++rep) {
            const int ch = tid + rep * 256, g = ch >> 4, ho = ch & 15;
            const float* cre = P.in[13] + ((size_t)(l * 32 + g) * 16 + ho) * 64;
            const float* cim = P.in[14] + ((size_t)(l * 32 + g) * 16 + ho) * 64;
            float4 cr[16], ci[16];
#pragma unroll
            for (int k = 0; k < 16; ++k) { cr[k] = *(const float4*)(cre + 4 * k); ci[k] = *(const float4*)(cim + 4 * k); }
            const float* hh = hst + g * 128;
            float acc = 0.f;
#pragma unroll
            for (int k = 0; k < 16; ++k) {
                const int p = 4 * k;
                acc += hh[p] * cr[k].x - hh[64 + p] * ci[k].x + hh[p + 1] * cr[k].y - hh[64 + p + 1] * ci[k].y
                     + hh[p + 2] * cr[k].z - hh[64 + p + 2] * ci[k].z + hh[p + 3] * cr[k].w - hh[64 + p + 3] * ci[k].w;
            }
            const float y = acc + P.in[15][l * 512 + ch] * row[OUB + ch];
            prow[OUB + ch] = f2bf(geluf_(y));
        }
        {
            const float v0 = row[OVC + tid], v1 = row[OVC + 256 + tid];
            float s_ = wave_sum(v0 + v1);
            if (lane == 0) red[wid] = s_;
            __syncthreads();
            const float mean = (red[0] + red[1] + red[2] + red[3]) * (1.0f / 512.0f);
            const float e0 = v0 - mean, e1 = v1 - mean;
            float q = wave_sum(e0 * e0 + e1 * e1);
            if (lane == 0) red[8 + wid] = q;
            __syncthreads();
            const float rstd = rsqrtf((red[8] + red[9] + red[10] + red[11]) * (1.0f / 512.0f) + 1e-5f);
#pragma unroll
            for (int rep = 0; rep < 2; ++rep) {
                const int ch = tid + rep * 256, g = ch >> 7;
                const float vn = (rep ? e1 : e0) * rstd * P.in[18][l * 512 + ch] + P.in[19][l * 512 + ch];
                P.out[O_VC + ((size_t)l * 128 + b) * 512 + ch] = vn;
                const float sg = P.in[20][(size_t)(l * 4 + g) * 128 * 128] * vn + P.in[21][(l * 4 + g) * 128];
                prow[OUC + ch] = f2bf(row[OUC + ch] * sg * siluf_(row[OZC + ch]));
            }
        }
    }
    __syncthreads();
}

__device__ __forceinline__ u16* gate_ptr(const Params& P, int b, int tok, int c) {
    if (b == 0) return (u16*)(P.ws + WS_MRG) + (size_t)tok * 1024 + c;
    if (b == 1) return (c < 768) ? ((u16*)(P.ws + WS_PROJ) + (size_t)tok * NPROJ + 512 + c) : ((u16*)(P.ws + WS_GX) + (size_t)tok * 256 + (c - 768));
    return (u16*)(P.ws + WS_PROJ) + (size_t)tok * NPROJ + 2816 + c;
}
template <int TM, int TN, int WM, int WN>
__device__ __forceinline__ void gate_tile(const Params& P, int l, int tok0, int gcol0, unsigned char* smem) {
    TILE_IDS
    const u16* xbf = (const u16*)(P.ws + WS_XBF);
    const u16* win = (const u16*)(P.ws + WS_WIN) + (size_t)l * NIN * 1024;
    f32x4 acc[TM][TN];
    ACC_ZERO(acc)
    gemm_any<TM, TN, WM, WN, true>(acc, win, OG + gcol0, 1024, xbf + (size_t)tok0 * 1024, 1024, 1024, smem);
    const int b = gcol0 >> 10;
#pragma unroll
    for (int i = 0; i < TM; ++i)
#pragma unroll
        for (int j = 0; j < TN; ++j) {
            const int tok = tok0 + (wn * TN + j) * 16 + fr, c = (gcol0 & 1023) + (wm * TM + i) * 16 + 4 * fq;
            const f32x4 a = acc[i][j];
            store_bf4(gate_ptr(P, b, tok, c), sigmoidf_(a[0]), sigmoidf_(a[1]), sigmoidf_(a[2]), sigmoidf_(a[3]));
        }
}
__device__ void phase2(const Params& P, int l, unsigned char* smem) {
    const bool gemm_first = blockIdx.x < (gridDim.x >> 1);
#pragma unroll 1
    for (int pass = 0; pass < 2; ++pass) {
        if ((pass == 0) == gemm_first) {
            XCD_TILE_LOOP(q, 512) gate_tile<8, 4, 2, 2>(P, l, (q >> 2) * 128, (q & 3) * 256, smem);
        } else {
            for (int it = blockIdx.x; it < 2816; it += gridDim.x) {
                if (it < 1024) attn_item(P, l, it, smem);
                else if (it < 1536) sgu_item(P, l, it - 1024, smem);
                else if (it < 1792) sample_item(P, l, (it - 1536) & 127, (it - 1536) >> 7, smem);
                else s5_item<false>(P, l, it - 1792, smem);
            }
        }
    }
}
__device__ void phase3(const Params& P, int l, unsigned char* smem) {
    XCD_TILE_LOOP(q, 1024) gate_tile<8, 4, 2, 2>(P, l, ((q & 511) >> 2) * 128, 1024 + (q >> 9) * 1024 + (q & 3) * 256, smem);
    for (int it = blockIdx.x; it < 1024 + 192; it += gridDim.x) {
        if (it < 1024) s5_item<true>(P, l, it, smem);
        else gate_tile<1, 2, 1, 4>(P, l, TP, (it - 1024) * 16, smem);
    }
}

template <int TM, int TN, int WM, int WN>
__device__ __forceinline__ void glu_tile(const Params& P, int l, int tok0, int col0, unsigned char* smem) {
    TILE_IDS
    u16* proj = (u16*)(P.ws + WS_PROJ);
    const u16* gw = (const u16*)(P.ws + WS_GLU) + (size_t)l * 512 * 512;
    f32x4 acc[TM][TN];
    ACC_ZERO(acc)
    gemm_accum<TM, TN, WM, WN>(acc, gw + (size_t)col0 * 512, 512, proj + (size_t)tok0 * NPROJ + OUB, NPROJ, 512, (u16*)smem);
    uint2 yy[TM][TN], zz[TM][TN];
    f32x4 gbv[TM];
#pragma unroll
    for (int i = 0; i < TM; ++i) {
        gbv[i] = *(const f32x4*)(P.in[17] + l * 512 + col0 + (wm * TM + i) * 16 + 4 * fq);
#pragma unroll
        for (int j = 0; j < TN; ++j) {
            const int tok = tok0 + (wn * TN + j) * 16 + fr, col = col0 + (wm * TM + i) * 16 + 4 * fq;
            const u16* rowp = proj + (size_t)tok * NPROJ;
            yy[i][j] = *(const uint2*)(rowp + OUB + col); zz[i][j] = *(const uint2*)(rowp + OZB + col);
        }
    }
#pragma unroll
    for (int i = 0; i < TM; ++i)
#pragma unroll
        for (int j = 0; j < TN; ++j) {
            const int tok = tok0 + (wn * TN + j) * 16 + fr, col = col0 + (wm * TM + i) * 16 + 4 * fq;
            const f32x4 gb = gbv[i];
            u16* rowp = proj + (size_t)tok * NPROJ;
            const uint2 y = yy[i][j], z = zz[i][j];
            const f32x4 a = acc[i][j];
            store_bf4(rowp + OZB + col, bflo(y.x) * sigmoidf_(a[0] + gb[0]) * siluf_(bflo(z.x)), bfhi(y.x) * sigmoidf_(a[1] + gb[1]) * siluf_(bfhi(z.x)),
                      bflo(y.y) * sigmoidf_(a[2] + gb[2]) * siluf_(bflo(z.y)), bfhi(y.y) * sigmoidf_(a[3] + gb[3]) * siluf_(bfhi(z.y)));
        }
}
__device__ void phase4(const Params& P, int l, unsigned char* smem) {
    for (int it = blockIdx.x; it < 32; it += gridDim.x) glu_tile<1, 2, 1, 4>(P, l, TP, it * 16, smem);
    XCD_TILE_LOOP(id, 512) glu_tile<4, 4, 2, 2>(P, l, (id >> 2) * 128, (id & 3) * 128, smem);
}

template <int TM, int TN, int WM, int WN>
__device__ __forceinline__ void merge_tile(const Params& P, int l, int tok0, int col0, unsigned char* smem) {
    TILE_IDS
    const u16* proj = (const u16*)(P.ws + WS_PROJ);
    const u16* wr = (const u16*)(P.ws + WS_WR) + (size_t)l * 3 * 1024 * 512;
    u16* mrg = (u16*)(P.ws + WS_MRG);
#pragma unroll 1
    for (int b = 0; b < 3; ++b) {
        f32x4 acc[TM][TN];
        ACC_ZERO(acc)
        const int yoff = (b == 0) ? OQ : ((b == 1) ? OZB : OUC);
        gemm_any<TM, TN, WM, WN>(acc, wr + (size_t)b * 1024 * 512, col0, 512, proj + (size_t)tok0 * NPROJ + yoff, NPROJ, 512, smem);
        const u16* gbase; int gstride;
        if (b == 0) { gbase = mrg + col0; gstride = 1024; }
        else if (b == 1) { if (col0 < 768) { gbase = proj + 512 + col0; gstride = NPROJ; } else { gbase = (const u16*)(P.ws + WS_GX) + (col0 - 768); gstride = 256; } }
        else { gbase = proj + 2816 + col0; gstride = NPROJ; }
        constexpr int IB = (TM >= 2) ? 2 : 1;
#pragma unroll
        for (int i0 = 0; i0 < TM; i0 += IB) {
            uint2 g[IB][TN], m[IB][TN];
#pragma unroll
            for (int ii = 0; ii < IB; ++ii)
#pragma unroll
                for (int j = 0; j < TN; ++j) {
                    const int tok = tok0 + (wn * TN + j) * 16 + fr, lc = (wm * TM + i0 + ii) * 16 + 4 * fq;
                    g[ii][j] = *(const uint2*)(gbase + (size_t)tok * gstride + lc);
                    m[ii][j] = make_uint2(0u, 0u);
                    if (b > 0) m[ii][j] = *(const uint2*)(mrg + (size_t)tok * 1024 + col0 + lc);
                }
#pragma unroll
            for (int ii = 0; ii < IB; ++ii)
#pragma unroll
                for (int j = 0; j < TN; ++j) {
                    const int tok = tok0 + (wn * TN + j) * 16 + fr, lc = (wm * TM + i0 + ii) * 16 + 4 * fq;
                    const f32x4 a = acc[i0 + ii][j];
                    store_bf4(mrg + (size_t)tok * 1024 + col0 + lc, bflo(m[ii][j].x) + bflo(g[ii][j].x) * a[0], bfhi(m[ii][j].x) + bfhi(g[ii][j].x) * a[1],
                              bflo(m[ii][j].y) + bflo(g[ii][j].y) * a[2], bfhi(m[ii][j].y) + bfhi(g[ii][j].y) * a[3]);
                }
            asm volatile("" ::: "memory");
        }
    }
}
__device__ void phase5(const Params& P, int l, unsigned char* smem) {
    for (int it = blockIdx.x; it < 64; it += gridDim.x) merge_tile<1, 2, 1, 4>(P, l, TP, it * 16, smem);
    XCD_TILE_LOOP(id, 512) merge_tile<8, 4, 2, 2>(P, l, (id >> 2) * 128, (id & 3) * 256, smem);
}

template <int TM, int TN, int WM, int WN>
__device__ __forceinline__ void oproj_tile(const Params& P, int l, int tok0, int col0, unsigned char* smem) {
    TILE_IDS
    const u16* mrg = (const u16*)(P.ws + WS_MRG);
    const u16* wo = (const u16*)(P.ws + WS_WO) + (size_t)l * 1024 * 1024;
    f32x4 acc[TM][TN];
    ACC_ZERO(acc)
    gemm_any<TM, TN, WM, WN>(acc, wo, col0, 1024, mrg + (size_t)tok0 * 1024, 1024, 1024, smem);
    constexpr int IB = (TM >= 2) ? 2 : 1;
#pragma unroll
    for (int i0 = 0; i0 < TM; i0 += IB) {
        f32x4 xr[IB][TN];
#pragma unroll
        for (int ii = 0; ii < IB; ++ii)
#pragma unroll
            for (int j = 0; j < TN; ++j) {
                const int tok = tok0 + (wn * TN + j) * 16 + fr, col = col0 + (wm * TM + i0 + ii) * 16 + 4 * fq;
                const float* res = (l == 0) ? ((tok < TP) ? (P.in[0] + (size_t)tok * 1024 + col) : (P.in[1] + (size_t)(tok - TP) * 1024 + col))
                                            : (P.out + (size_t)tok * 1024 + col);
                xr[ii][j] = __builtin_nontemporal_load((const f32x4*)res);
            }
#pragma unroll
        for (int ii = 0; ii < IB; ++ii)
#pragma unroll
            for (int j = 0; j < TN; ++j) {
                const int tok = tok0 + (wn * TN + j) * 16 + fr, col = col0 + (wm * TM + i0 + ii) * 16 + 4 * fq;
                *(f32x4*)(P.out + (size_t)tok * 1024 + col) = xr[ii][j] * ALPHA_C + acc[i0 + ii][j];
            }
        asm volatile("" ::: "memory");
    }
}
__device__ void phase6(const Params& P, int l, unsigned char* smem) {
    for (int it = blockIdx.x; it < 64; it += gridDim.x) oproj_tile<1, 2, 1, 4>(P, l, TP, it * 16, smem);
    XCD_TILE_LOOP(id, 512) oproj_tile<8, 4, 2, 2>(P, l, (id >> 2) * 128, (id & 3) * 256, smem);
}

__device__ void phase7(const Params& P, int l) {
    const int tid = otid(), lane = tid & 63;
    const int gw = blockIdx.x * 4 + (tid >> 6), nw = gridDim.x * 4;
    u16* xbf = (u16*)(P.ws + WS_XBF);
    const float* g = P.in[24] + l * 1024; const float* bta = P.in[25] + l * 1024;
    for (int row0 = gw; row0 < TT; row0 += 2 * nw) {
        const int row1 = row0 + nw;
        const bool has1 = row1 < TT;
        float* xr0 = P.out + (size_t)row0 * 1024;
        float* xr1 = P.out + (size_t)(has1 ? row1 : row0) * 1024;
        f32x4 v0[4], v1[4];
#pragma unroll
        for (int i = 0; i < 4; ++i) { v0[i] = __builtin_nontemporal_load((const f32x4*)(xr0 + i * 256 + lane * 4)); v1[i] = __builtin_nontemporal_load((const f32x4*)(xr1 + i * 256 + lane * 4)); }
        float s0 = 0.f, s1 = 0.f;
#pragma unroll
        for (int i = 0; i < 4; ++i) { s0 += (v0[i][0] + v0[i][1]) + (v0[i][2] + v0[i][3]); s1 += (v1[i][0] + v1[i][1]) + (v1[i][2] + v1[i][3]); }
        const float m0 = wave_sum(s0) * (1.0f / 1024.0f), m1 = wave_sum(s1) * (1.0f / 1024.0f);
        float q0 = 0.f, q1 = 0.f;
#pragma unroll
        for (int i = 0; i < 4; ++i) {
            v0[i] = v0[i] - m0; q0 += (v0[i][0] * v0[i][0] + v0[i][1] * v0[i][1]) + (v0[i][2] * v0[i][2] + v0[i][3] * v0[i][3]);
            v1[i] = v1[i] - m1; q1 += (v1[i][0] * v1[i][0] + v1[i][1] * v1[i][1]) + (v1[i][2] * v1[i][2] + v1[i][3] * v1[i][3]);
        }
        const float r0 = rsqrtf(wave_sum(q0) * (1.0f / 1024.0f) + 1e-5f), r1 = rsqrtf(wave_sum(q1) * (1.0f / 1024.0f) + 1e-5f);
#pragma unroll
        for (int i = 0; i < 4; ++i) {
            const int c = i * 256 + lane * 4;
            const f32x4 gg = *(const f32x4*)(g + c), bb = *(const f32x4*)(bta + c);
            const f32x4 y0 = v0[i] * r0 * gg + bb, y1 = v1[i] * r1 * gg + bb;
            __builtin_nontemporal_store(y0, (f32x4*)(xr0 + c));
            if (l == 0) store_bf4(xbf + xt_ofs(row0, c), y0[0], y0[1], y0[2], y0[3]);
            if (has1) {
                __builtin_nontemporal_store(y1, (f32x4*)(xr1 + c));
                if (l == 0) store_bf4(xbf + xt_ofs(row1, c), y1[0], y1[1], y1[2], y1[3]);
            }
        }
    }
}

#define XB_TMO      128
#define XB_XCNT(j)  (256  + 64 * (j))
#define XB_XSUB(j)  (1280 + 64 * (j))
#define XB_XGEN(j)  (2304 + 64 * (j))
#define XB_TOP      3328
#define XB_TOPGEN   3392
#define XCD_BAR_WORDS 3456
#define XB_SPIN_CAP (1u << 18)
#define LAS __attribute__((address_space(3)))
__device__ __forceinline__ unsigned xb_ld(unsigned* p)              { return __hip_atomic_load(p, __ATOMIC_RELAXED, __HIP_MEMORY_SCOPE_AGENT); }
__device__ __forceinline__ unsigned xb_add(unsigned* p, unsigned v) { return __hip_atomic_fetch_add(p, v, __ATOMIC_RELAXED, __HIP_MEMORY_SCOPE_AGENT); }
__device__ __forceinline__ unsigned xb_xcc_id() { return (unsigned)__builtin_amdgcn_s_getreg((3 << 11) | 20) & 0xFu; }
#define XB_SPIN(cond, bar) do { unsigned _sp = 0; while (cond) { __builtin_amdgcn_s_sleep(1); \
    if ((++_sp & 255u) == 0u) { if (xb_ld(&(bar)[XB_TMO])) break; if (_sp > XB_SPIN_CAP) { atomicAdd(&(bar)[XB_TMO], 1u); break; } } } } while (0)
struct XcdBarrier { unsigned* bar; unsigned x; volatile LAS unsigned* st; };
__device__ __forceinline__ XcdBarrier xcd_barrier_post(unsigned* bar, volatile LAS unsigned* st) {
    XcdBarrier b; b.bar = bar; b.x = xb_xcc_id(); b.st = st;
    if (threadIdx.x == 0) (void)xb_add(&bar[XB_XCNT(b.x)], 1u);
    return b;
}
__device__ __forceinline__ void xcd_barrier_complete(unsigned* bar, unsigned x, unsigned& nloc, unsigned& nx) {
    const unsigned G = gridDim.x * gridDim.y * gridDim.z;
    unsigned sum, cnt, mine, sp = 0u;
    for (;;) {
        sum = 0u; cnt = 0u; mine = 0u;
#pragma unroll
        for (unsigned j = 0; j < 16; ++j) { const unsigned c = xb_ld(&bar[XB_XCNT(j)]); sum += c; cnt += (c > 0u) ? 1u : 0u; mine = (j == x) ? c : mine; }
        if (sum == G) break;
        __builtin_amdgcn_s_sleep(1);
        if ((++sp & 255u) == 0u) { if (xb_ld(&bar[XB_TMO])) break; if (sp > XB_SPIN_CAP) { atomicAdd(&bar[XB_TMO], 1u); break; } }
    }
    nloc = mine > 0u ? mine : 1u; nx = cnt > 0u ? cnt : 1u;
}
__device__ __forceinline__ void xcd_barrier(const XcdBarrier& b) {
    asm volatile("s_waitcnt vmcnt(0)" ::: "memory");
    __syncthreads();
    if (threadIdx.x == 0) {
        unsigned* bar = b.bar;
        __builtin_amdgcn_s_waitcnt(0);
        unsigned nloc = b.st[0], nx = b.st[1];
        if (nloc == 0u) { xcd_barrier_complete(bar, b.x, nloc, nx); b.st[0] = nloc; b.st[1] = nx; }
        const unsigned old = xb_add(&bar[XB_XSUB(b.x)], 1u);
        const unsigned gen = old / nloc;
        if (old + 1u == (gen + 1u) * nloc) {
            __builtin_amdgcn_fence(__ATOMIC_RELEASE, "agent");
            asm volatile("s_waitcnt vmcnt(0)" ::: "memory");
            const unsigned og = xb_add(&bar[XB_TOP], 1u);
            const unsigned tg = og / nx;
            if (og + 1u == (tg + 1u) * nx) xb_add(&bar[XB_TOPGEN], 1u);
            else XB_SPIN(xb_ld(&bar[XB_TOPGEN]) == tg, bar);
            __builtin_amdgcn_fence(__ATOMIC_ACQUIRE, "agent");
            xb_add(&bar[XB_XGEN(b.x)], 1u);
            asm volatile("s_waitcnt vmcnt(0)" ::: "memory");
        } else {
            XB_SPIN(xb_ld(&bar[XB_XGEN(b.x)]) == gen, bar);
            __builtin_amdgcn_fence(__ATOMIC_ACQUIRE, "agent");
            asm volatile("s_waitcnt vmcnt(0)" ::: "memory");
        }
    }
    __syncthreads();
}

constexpr int N_PHASES = 15;
#ifndef DUPM
#define DUPM 0
#endif
__global__ void __launch_bounds__(256, 2) mk_fwd(Params P, int ph_lo, int ph_hi, int coop) {
    __shared__ __attribute__((aligned(16))) unsigned char smem[SMEM_BYTES];
    __shared__ uint4 xb_words;
    if (threadIdx.x == 0) xb_words = make_uint4(0u, 0u, 0u, 0u);
    __syncthreads();
    XcdBarrier xb; xb.bar = (unsigned*)(P.ws + WS_BAR); xb.x = 0; xb.st = (volatile LAS unsigned*)&xb_words;
    if (coop) xb = xcd_barrier_post((unsigned*)(P.ws + WS_BAR), (volatile LAS unsigned*)&xb_words);
    if (coop > 1) cg::this_grid().sync();
    for (int ph = ph_lo; ph < ph_hi; ++ph) {
        if (coop && ph > ph_lo) xcd_barrier(xb);
        const int l = (ph == 0) ? 0 : (ph - 1) / 7, k = (ph == 0) ? 0 : ((ph - 1) % 7 + 1);
        {
            switch (k) {
                case 0: phase0(P, smem); break;
                case 1: phase1(P, l, smem); break;
                case 2: phase2(P, l, smem); break;
                case 3: phase3(P, l, smem); break;
                case 4: phase4(P, l, smem); break;
                case 5: phase5(P, l, smem); break;
                case 6: phase6(P, l, smem); break;
                default: phase7(P, l); break;
            }
        }
    }
}

extern "C" void kernel_launch(void* const* d_in, const int* in_sizes, int n_in, void* d_out, int out_size, void* d_ws, size_t ws_size, hipStream_t stream) {
    (void)in_sizes; (void)n_in; (void)out_size; (void)ws_size;
    Params P{};
    for (int i = 0; i < 26; ++i) P.in[i] = (const float*)d_in[i];
    P.out = (float*)d_out;
    P.ws = (unsigned char*)d_ws;
    static int grid_blocks = 0;
    if (!grid_blocks) {
        int dev = 0, cus = 0, per_cu = 0;
        hipGetDevice(&dev);
        hipDeviceGetAttribute(&cus, hipDeviceAttributeMultiprocessorCount, dev);
        hipOccupancyMaxActiveBlocksPerMultiprocessor(&per_cu, mk_fwd, 256, 0);
        if (per_cu > 2) per_cu = 2;
        if (per_cu < 1) per_cu = 1;
        grid_blocks = cus * per_cu;
    }
#if ML
    for (int ph = 0; ph < N_PHASES; ++ph) {
        hipLaunchKernelGGL(mk_fwd, dim3(grid_blocks), dim3(256), 0, stream, P, ph, ph + 1, 0);
    }
#else
    (void)hipMemsetAsync((unsigned char*)d_ws + WS_BAR, 0, 16384, stream);
    int lo = 0, hi = N_PHASES, coop = 1;
    void* args[] = {&P, &lo, &hi, &coop};
    hipError_t e = hipLaunchCooperativeKernel((void*)mk_fwd, dim3(grid_blocks), dim3(256), args, 0, stream);
    if (e != hipSuccess) fprintf(stderr, "cooperative launch failed: %s (grid %d)\n", hipGetErrorString(e), grid_blocks);
#endif
}
```

```cpp
#include <hip/hip_runtime.h>
#include <hip/hip_cooperative_groups.h>
#include <cstdio>
#include <cstdint>
namespace cg = cooperative_groups;

#ifndef ML
#define ML 0
#endif

typedef unsigned short u16;
typedef short bf16x8 __attribute__((ext_vector_type(8)));
typedef short bf16x4 __attribute__((ext_vector_type(4)));
typedef float f32x4 __attribute__((ext_vector_type(4)));

constexpr int DM = 1024, TP = 16384, TS = 128, TT = TP + TS, SEQL = 8192, NPROJ = 3840, NIN = 6912;
constexpr int OQ = 0, OKK = 512, OV = 640, OZA = 768, OUB = 1280, OZB = 1792, OUC = 2304, OVC = 2816, OZC = 3328, OG = 3840;
constexpr float ALPHA_C = 1.41421356237f;

constexpr size_t WS_PROJ = 0;
constexpr size_t WS_XBF  = WS_PROJ + (size_t)TT * NPROJ * 2;
constexpr size_t WS_MRG  = WS_XBF + (size_t)TT * DM * 2;
constexpr size_t WS_WIN  = WS_MRG + (size_t)TT * DM * 2;
constexpr size_t WS_WR   = WS_WIN + (size_t)2 * NIN * DM * 2;
constexpr size_t WS_WO   = WS_WR + (size_t)2 * 3 * 1024 * 512 * 2;
constexpr size_t WS_GLU  = WS_WO + (size_t)2 * 1024 * 1024 * 2;
constexpr size_t WS_SGUW = WS_GLU + (size_t)2 * 512 * 512 * 2;
constexpr size_t WS_VT   = WS_SGUW + (size_t)2 * 4 * 128 * 128 * 2;
constexpr size_t WS_ABAR = WS_VT + (size_t)2 * 2 * 64 * 8192 * 2;
constexpr size_t WS_A128 = WS_ABAR + (size_t)2 * 32 * 64 * 2 * 4;
constexpr size_t WS_BBT  = WS_A128 + (size_t)2 * 32 * 64 * 2 * 4;
constexpr size_t WS_CMT  = WS_BBT + (size_t)2 * 32 * 128 * 16 * 2;
constexpr size_t WS_SST  = WS_CMT + (size_t)2 * 32 * 16 * 128 * 2;
constexpr size_t WS_GX   = WS_SST + (size_t)128 * 32 * 128 * 4;
constexpr size_t WS_BAR  = WS_GX + (size_t)TT * 256 * 2;
constexpr size_t WS_END  = WS_BAR + 16384;

constexpr size_t O_YP = 0, O_YS = 16777216, O_KP = 16908288, O_VP = 16973824, O_HRP = 17039360, O_HIP = 17047552,
                 O_KS = 17055744, O_VS = 17088512, O_HRS = 17121280, O_HIS = 17645568, O_VC = 18169856;

struct Params {
    const float* in[26];
    float* out;
    unsigned char* ws;
};

constexpr int SMEM_BYTES = 73728;
constexpr int LDT = 72;

__device__ __forceinline__ unsigned cvt_pk_bf16(float lo, float hi) { unsigned r; asm volatile("v_cvt_pk_bf16_f32 %0, %1, %2" : "=v"(r) : "v"(lo), "v"(hi)); return r; }
__device__ __forceinline__ u16 f2bf(float f) { return (u16)(cvt_pk_bf16(f, 0.f) & 0xffffu); }
__device__ __forceinline__ float bf2f(u16 h) { return __uint_as_float(((unsigned)h) << 16); }
__device__ __forceinline__ float bflo(unsigned w) { return __uint_as_float(w << 16); }
__device__ __forceinline__ float bfhi(unsigned w) { return __uint_as_float(w & 0xffff0000u); }
__device__ __forceinline__ float sigmoidf_(float x) { return 1.0f / (1.0f + __expf(-x)); }
__device__ __forceinline__ float siluf_(float x) { return x / (1.0f + __expf(-x)); }
__device__ __forceinline__ float geluf_(float y) { const float z = 0.7978845608f * (y + 0.044715f * y * y * y); return y / (1.0f + __expf(-2.0f * z)); }
__device__ __forceinline__ f32x4 mfma32(bf16x8 a, bf16x8 b, f32x4 c) { return __builtin_amdgcn_mfma_f32_16x16x32_bf16(a, b, c, 0, 0, 0); }
__device__ __forceinline__ f32x4 mfma16(bf16x4 a, bf16x4 b, f32x4 c) { return __builtin_amdgcn_mfma_f32_16x16x16bf16_1k(a, b, c, 0, 0, 0); }
__device__ __forceinline__ void store_bf4(u16* p, float a, float b, float c, float d) { uint2 w; w.x = cvt_pk_bf16(a, b); w.y = cvt_pk_bf16(c, d); *(uint2*)p = w; }
__device__ __forceinline__ int otid() { int t = threadIdx.x; asm volatile("" : "+v"(t)); return t; }
__device__ __forceinline__ float wave_sum(float v) {
#pragma unroll
    for (int o = 32; o > 0; o >>= 1) v += __shfl_xor(v, o);
    return v;
}
__device__ __forceinline__ float wave_max(float v) {
#pragma unroll
    for (int o = 32; o > 0; o >>= 1) v = fmaxf(v, __shfl_xor(v, o));
    return v;
}

__device__ __forceinline__ size_t wt_ofs(int n, int k, int K) { return ((size_t)((n >> 8) * (K >> 5) + (k >> 5))) * 8192 + (size_t)((n & 255) * 32 + (k & 31)); }

__device__ __forceinline__ size_t xt_ofs(int tok, int k) { return ((size_t)((tok >> 7) * 32 + (k >> 5))) * 4096 + (size_t)((tok & 127) * 32 + (k & 31)); }

template <int TM, int TN, int WM, int WN, bool WT = false, bool XT = false>
__device__ __forceinline__ void gemm_accum(f32x4 (&acc)[TM][TN], const u16* __restrict__ W, const int ldw,
                                           const u16* __restrict__ X, const int ldx, const int K, u16* lds, const int wn0 = 0) {
    constexpr int WR = 16 * TM * WM, XR = 16 * TN * WN, WCH = WR * 8, XCH = XR * 8;
    constexpr int NW = (WCH + 255) / 256, NX = (XCH + 255) / 256;
    static_assert(NW <= 4 && NX <= 4, "tile too large");
    u16* As = lds;
    u16* Bs = lds + 2 * WR * LDT;
    const int tid = otid(), lane = tid & 63, wid = tid >> 6, wm = wid / WN, wn = wid % WN, fr = lane & 15, fq = lane >> 4;
    const int lrow = tid >> 3, lcol = (tid & 7) * 8;
    const u16* Wp = W + (size_t)lrow * ldw + lcol;
    const u16* Xp = X + (size_t)lrow * ldx + lcol;
    uint4 rw0, rw1, rw2, rw3, rx0, rx1, rx2, rx3;
    rw0 = rw1 = rw2 = rw3 = rx0 = rx1 = rx2 = rx3 = make_uint4(0, 0, 0, 0);
#define GW_(j, k0) if (j < NW && ((WCH % 256 == 0) || (tid + 256 * j < WCH))) rw##j = WT ? *(const uint4*)(W + wt_ofs(wn0 + lrow + 32 * j, (k0) + lcol, ldw)) : *(const uint4*)(Wp + (size_t)(32 * j) * ldw + (k0));
#define GX_(j, k0) if (j < NX && ((XCH % 256 == 0) || (tid + 256 * j < XCH))) rx##j = XT ? *(const uint4*)(X + (size_t)(((k0) + lcol) >> 5) * 4096 + (lrow + 32 * j) * 32 + (((k0) + lcol) & 31)) : *(const uint4*)(Xp + (size_t)(32 * j) * ldx + (k0));
#define SW_(j, nb) if (j < NW && ((WCH % 256 == 0) || (tid + 256 * j < WCH))) *(uint4*)(As + (nb) * WR * LDT + (lrow + 32 * j) * LDT + lcol) = rw##j;
#define SX_(j, nb) if (j < NX && ((XCH % 256 == 0) || (tid + 256 * j < XCH))) *(uint4*)(Bs + (nb) * XR * LDT + (lrow + 32 * j) * LDT + lcol) = rx##j;
    GW_(0, 0) GW_(1, 0) GW_(2, 0) GW_(3, 0) GX_(0, 0) GX_(1, 0) GX_(2, 0) GX_(3, 0)
    SW_(0, 0) SW_(1, 0) SW_(2, 0) SW_(3, 0) SX_(0, 0) SX_(1, 0) SX_(2, 0) SX_(3, 0)
    __syncthreads();
    int nk = K >> 6;
    asm volatile("" : "+s"(nk));
    for (int kt = 0; kt < nk; ++kt) {
        const bool more = (kt + 1 < nk);
        if (more) {
            const int k0 = (kt + 1) << 6;
            GW_(0, k0) GW_(1, k0) GW_(2, k0) GW_(3, k0) GX_(0, k0) GX_(1, k0) GX_(2, k0) GX_(3, k0)
        }
        const u16* a_ = As + (kt & 1) * WR * LDT + (wm * TM * 16 + fr) * LDT + fq * 8;
        const u16* b_ = Bs + (kt & 1) * XR * LDT + (wn * TN * 16 + fr) * LDT + fq * 8;
#pragma unroll
        for (int ks = 0; ks < 2; ++ks) {
            bf16x8 bfr[TN];
#pragma unroll
            for (int j = 0; j < TN; ++j) bfr[j] = *(const bf16x8*)(b_ + j * 16 * LDT + ks * 32);
#pragma unroll
            for (int i = 0; i < TM; ++i) {
                const bf16x8 af = *(const bf16x8*)(a_ + i * 16 * LDT + ks * 32);
#pragma unroll
                for (int j = 0; j < TN; ++j) acc[i][j] = mfma32(af, bfr[j], acc[i][j]);
            }
        }
        if (more) {
            const int nb = (kt + 1) & 1;
            SW_(0, nb) SW_(1, nb) SW_(2, nb) SW_(3, nb) SX_(0, nb) SX_(1, nb) SX_(2, nb) SX_(3, nb)
        }
        __syncthreads();
    }
#undef GW_
#undef GX_
#undef SW_
#undef SX_
}


template <int OFF>
__device__ __forceinline__ bf16x8 lds_rd128(unsigned addr) {
    bf16x8 v;
    asm volatile("ds_read_b128 %0, %1 offset:%2" : "=v"(v) : "v"(addr), "n"(OFF) : "memory");
    return v;
}
template <bool XT>
__device__ __forceinline__ void gemm_big(f32x4 (&acc)[8][4], const u16* __restrict__ W, const int ldw,
                                         const u16* __restrict__ X, const int ldx, const int K, unsigned char* lds) {
    const int tid = otid(), lane = tid & 63, wid = tid >> 6, wm = wid >> 1, wn = wid & 1, fr = lane & 15, fq = lane >> 4;
    constexpr int STG = 24576;
    const u16* Wp = W + tid * 8;
    const u16* Xp = XT ? (X + tid * 8) : (X + (size_t)(tid >> 2) * ldx + (tid & 3) * 8);
    const size_t xs1 = XT ? (size_t)2048 : (size_t)64 * ldx; const int xks = XT ? 128 : 1;
    unsigned char* sdst = lds + tid * 16;
    const unsigned lbase = (unsigned)(size_t)(__attribute__((address_space(3))) unsigned char*)lds;
    const unsigned a_off = lbase + (wm * 128 + fr) * 64 + fq * 16;
    const unsigned b_off = lbase + 16384 + (wn * 64 + fr) * 64 + fq * 16;
#define BIG_ISSUE(stg, k0) { unsigned char* sb_ = sdst + (stg) * STG; \
        __builtin_amdgcn_global_load_lds((const unsigned*)(Wp + (size_t)(k0) * 256), (unsigned*)(sb_), 16, 0, 0); \
        __builtin_amdgcn_global_load_lds((const unsigned*)(Wp + (size_t)(k0) * 256 + 2048), (unsigned*)(sb_ + 4096), 16, 0, 0); \
        __builtin_amdgcn_global_load_lds((const unsigned*)(Wp + (size_t)(k0) * 256 + 4096), (unsigned*)(sb_ + 8192), 16, 0, 0); \
        __builtin_amdgcn_global_load_lds((const unsigned*)(Wp + (size_t)(k0) * 256 + 6144), (unsigned*)(sb_ + 12288), 16, 0, 0); \
        __builtin_amdgcn_global_load_lds((const unsigned*)(Xp + (size_t)(k0) * xks), (unsigned*)(sb_ + 16384), 16, 0, 0); \
        __builtin_amdgcn_global_load_lds((const unsigned*)(Xp + (size_t)(k0) * xks + xs1), (unsigned*)(sb_ + 20480), 16, 0, 0); }
    int nk = K >> 5;
    asm volatile("" : "+s"(nk));
    asm volatile("s_waitcnt vmcnt(0)" ::: "memory");
    BIG_ISSUE(0, 0)
    if (nk > 1) BIG_ISSUE(1, 32)
    int stage = 0;
    for (int kt = 0; kt < nk; ++kt) {
        if (kt + 1 < nk) asm volatile("s_waitcnt vmcnt(6)" ::: "memory"); else asm volatile("s_waitcnt vmcnt(0)" ::: "memory");
        __builtin_amdgcn_s_barrier();
        asm volatile("" ::: "memory");
        if (kt + 2 < nk) { int s2 = stage + 2; if (s2 >= 3) s2 -= 3; BIG_ISSUE(s2, (kt + 2) << 5) }
        const unsigned aa = a_off + stage * STG, bb = b_off + stage * STG;
        bf16x8 b0 = lds_rd128<0>(bb), b1 = lds_rd128<1024>(bb), b2 = lds_rd128<2048>(bb), b3 = lds_rd128<3072>(bb);
        bf16x8 a0 = lds_rd128<0>(aa), a1 = lds_rd128<1024>(aa), a2 = lds_rd128<2048>(aa), a3 = lds_rd128<3072>(aa);
        bf16x8 a4 = lds_rd128<4096>(aa), a5 = lds_rd128<5120>(aa), a6 = lds_rd128<6144>(aa), a7 = lds_rd128<7168>(aa);
#define BIG_ROW(i, av) acc[i][0] = mfma32(av, b0, acc[i][0]); acc[i][1] = mfma32(av, b1, acc[i][1]); acc[i][2] = mfma32(av, b2, acc[i][2]); acc[i][3] = mfma32(av, b3, acc[i][3]);
        asm volatile("s_waitcnt lgkmcnt(7)" : "+v"(b0), "+v"(b1), "+v"(b2), "+v"(b3), "+v"(a0) :: "memory");
        BIG_ROW(0, a0)
        asm volatile("s_waitcnt lgkmcnt(6)" : "+v"(a1) :: "memory");
        BIG_ROW(1, a1)
        asm volatile("s_waitcnt lgkmcnt(5)" : "+v"(a2) :: "memory");
        BIG_ROW(2, a2)
        asm volatile("s_waitcnt lgkmcnt(4)" : "+v"(a3) :: "memory");
        BIG_ROW(3, a3)
        asm volatile("s_waitcnt lgkmcnt(3)" : "+v"(a4) :: "memory");
        BIG_ROW(4, a4)
        asm volatile("s_waitcnt lgkmcnt(2)" : "+v"(a5) :: "memory");
        BIG_ROW(5, a5)
        asm volatile("s_waitcnt lgkmcnt(1)" : "+v"(a6) :: "memory");
        BIG_ROW(6, a6)
        asm volatile("s_waitcnt lgkmcnt(0)" : "+v"(a7) :: "memory");
        BIG_ROW(7, a7)
#undef BIG_ROW
        stage = (stage == 2) ? 0 : stage + 1;
    }
#undef BIG_ISSUE
    __syncthreads();
}
template <int TM, int TN, int WM, int WN, bool XT = false>
__device__ __forceinline__ void gemm_any(f32x4 (&acc)[TM][TN], const u16* __restrict__ Wmat, const int n0, const int ldw,
                                         const u16* __restrict__ X, const int ldx, const int K, unsigned char* lds) {
    if constexpr (TM == 8) gemm_big<XT>(acc, Wmat + (size_t)n0 * ldw, ldw, X, ldx, K, lds);
    else gemm_accum<TM, TN, WM, WN, true, XT>(acc, Wmat, ldw, X, ldx, K, (u16*)lds, n0);
}

#define ACC_ZERO(a) { _Pragma("unroll") for (int i_ = 0; i_ < TM; ++i_) { _Pragma("unroll") for (int j_ = 0; j_ < TN; ++j_) a[i_][j_] = (f32x4){0.f, 0.f, 0.f, 0.f}; } }
#define TILE_IDS const int tid = otid(), lane = tid & 63, wid = tid >> 6, wm = wid / WN, wn = wid % WN, fr = lane & 15, fq = lane >> 4; (void)tid; (void)wm; (void)wn;

struct TrJob { const float* src; u16* dst; int K, N, k0, n0, tiled; };
__device__ __forceinline__ TrJob tr_job(const Params& P, int id) {
    TrJob j; int t; j.tiled = 1;
    if (id < 3456) { const int l = id / 1728; t = id % 1728; j.K = 1024; j.N = NIN; j.src = P.in[6] + (size_t)l * 1024 * NIN; j.dst = (u16*)(P.ws + WS_WIN) + (size_t)l * NIN * 1024; }
    else if (id < 4224) { const int m = (id - 3456) / 128; t = (id - 3456) % 128; j.K = 512; j.N = 1024; j.src = P.in[22] + (size_t)m * 512 * 1024; j.dst = (u16*)(P.ws + WS_WR) + (size_t)m * 1024 * 512; }
    else if (id < 4736) { const int l = (id - 4224) / 256; t = (id - 4224) % 256; j.K = 1024; j.N = 1024; j.src = P.in[23] + (size_t)l * 1024 * 1024; j.dst = (u16*)(P.ws + WS_WO) + (size_t)l * 1024 * 1024; }
    else { const int l = (id - 4736) / 64; t = (id - 4736) % 64; j.tiled = 0; j.K = 512; j.N = 512; j.src = P.in[16] + (size_t)l * 512 * 512; j.dst = (u16*)(P.ws + WS_GLU) + (size_t)l * 512 * 512; }
    const int ntn = j.N / 64; j.k0 = (t / ntn) * 64; j.n0 = (t % ntn) * 64;
    return j;
}

__device__ void phase0(const Params& P, unsigned char* smem) {
    float* tl = (float*)smem;
    u16* ws16;
    const int tid = otid();
    {
        const int n = tid & 63, kk = tid >> 6, k2 = (tid & 31) * 2, nn = tid >> 5;
        float r[16];
        int id = blockIdx.x;
        TrJob j;
        if (id < 4864) { j = tr_job(P, id);
#pragma unroll
            for (int i = 0; i < 16; ++i) r[i] = __builtin_nontemporal_load(&j.src[(size_t)(j.k0 + kk + 4 * i) * j.N + j.n0 + n]); }
        while (id < 4864) {
#pragma unroll
            for (int i = 0; i < 16; ++i) tl[(kk + 4 * i) * 65 + n] = r[i];
            __syncthreads();
            const int idn = id + gridDim.x;
            TrJob jn = j;
            if (idn < 4864) { jn = tr_job(P, idn);
#pragma unroll
                for (int i = 0; i < 16; ++i) r[i] = __builtin_nontemporal_load(&jn.src[(size_t)(jn.k0 + kk + 4 * i) * jn.N + jn.n0 + n]); }
#pragma unroll
            for (int i = 0; i < 8; ++i) { const int nr = nn + 8 * i; const size_t o = j.tiled ? wt_ofs(j.n0 + nr, j.k0 + k2, j.K) : ((size_t)(j.n0 + nr) * j.K + j.k0 + k2);
                *(unsigned*)(j.dst + o) = cvt_pk_bf16(tl[k2 * 65 + nr], tl[(k2 + 1) * 65 + nr]); }
            __syncthreads();
            j = jn; id = idn;
        }
    }
    const int gtid = blockIdx.x * 256 + tid, gsz = gridDim.x * 256;
    ws16 = (u16*)(P.ws + WS_XBF);
    for (int i0 = gtid; i0 < TT * 128; i0 += 4 * gsz) {
        float4 a[4], b[4];
#pragma unroll
        for (int u = 0; u < 4; ++u) {
            const int i = i0 + u * gsz;
            if (i < TT * 128) {
                const int r = i >> 7, c = (i & 127) * 8;
                const float* sp = (r < TP) ? (P.in[0] + (size_t)r * 1024 + c) : (P.in[1] + (size_t)(r - TP) * 1024 + c);
                { const f32x4 t0 = __builtin_nontemporal_load((const f32x4*)sp), t1 = __builtin_nontemporal_load((const f32x4*)(sp + 4));
                  a[u] = make_float4(t0[0], t0[1], t0[2], t0[3]); b[u] = make_float4(t1[0], t1[1], t1[2], t1[3]); }
            }
        }
#pragma unroll
        for (int u = 0; u < 4; ++u) {
            const int i = i0 + u * gsz;
            if (i < TT * 128) {
                const int r = i >> 7, c = (i & 127) * 8;
                uint4 w; w.x = cvt_pk_bf16(a[u].x, a[u].y); w.y = cvt_pk_bf16(a[u].z, a[u].w); w.z = cvt_pk_bf16(b[u].x, b[u].y); w.w = cvt_pk_bf16(b[u].z, b[u].w);
                *(uint4*)(ws16 + xt_ofs(r, c)) = w;
            }
        }
    }
    ws16 = (u16*)(P.ws + WS_SGUW);
    for (int i = gtid; i < 2 * 4 * 128 * 128; i += gsz) {
        const int s_ = i & 127, t = (i >> 7) & 127;
        ws16[i] = (s_ <= t) ? f2bf(P.in[20][i]) : (u16)0;
    }
    for (int t = gtid; t < 65536; t += gsz) {
        const int i = t >> 4, h = t & 15;
        const int p = i & 63, g = (i >> 6) & 31, l = i >> 11;
        const float lr = P.in[8][i], li = P.in[9][i], dt = expf(P.in[10][l * 32 + g]);
        const float br = P.in[11][t], bi = P.in[12][t];
        const float cre = P.in[13][((size_t)(l * 32 + g) * 16 + h) * 64 + p], cim = P.in[14][((size_t)(l * 32 + g) * 16 + h) * 64 + p];
        const float mag = expf(lr * dt), ang = li * dt;
        const float ar = mag * cosf(ang), ai = mag * sinf(ang);
        const float den = lr * lr + li * li;
        const float cr = ((ar - 1.0f) * lr + ai * li) / den, ci = (ai * lr - (ar - 1.0f) * li) / den;
        if (h == 0) {
            float* abar = (float*)(P.ws + WS_ABAR); abar[2 * i] = ar; abar[2 * i + 1] = ai;
            float pr = ar, pi = ai;
#pragma unroll
            for (int k = 0; k < 7; ++k) { const float nr = pr * pr - pi * pi, ni = 2.0f * pr * pi; pr = nr; pi = ni; }
            float* a128 = (float*)(P.ws + WS_A128); a128[2 * i] = pr; a128[2 * i + 1] = pi;
        }
        u16* bbt = (u16*)(P.ws + WS_BBT) + (size_t)(l * 32 + g) * 128 * 16;
        bbt[p * 16 + h] = f2bf(cr * br - ci * bi);
        bbt[(64 + p) * 16 + h] = f2bf(cr * bi + ci * br);
        u16* cmt = (u16*)(P.ws + WS_CMT) + (size_t)(l * 32 + g) * 16 * 128;
        cmt[h * 128 + p] = f2bf(cre);
        cmt[h * 128 + 64 + p] = f2bf(-cim);
    }
}

#define XCD_TILE_LOOP(q, NT) for (int S_ = (int)gridDim.x >> 3, ch_ = (int)blockIdx.x & 7, q = ch_ * S_ + ((int)blockIdx.x >> 3); ch_ * S_ < (NT); ch_ += 8, q = ch_ * S_ + ((int)blockIdx.x >> 3)) if (q < (NT))

__device__ void phase1(const Params& P, int l, unsigned char* smem) {
    constexpr int TM = 8, TN = 4, WM = 2, WN = 2;
    TILE_IDS
    u16* proj = (u16*)(P.ws + WS_PROJ);
    const u16* xbf = (const u16*)(P.ws + WS_XBF);
    const u16* win = (const u16*)(P.ws + WS_WIN) + (size_t)l * NIN * 1024;
    u16* vT = (u16*)(P.ws + WS_VT);
    XCD_TILE_LOOP(id, 129 * 15) {
        const int pnl = id / 387, q5 = id % 387, tm = q5 / 3, tn = pnl * 3 + q5 % 3;
        const int tok0 = tm * 128, col0 = tn * 256;
        f32x4 acc[TM][TN];
        ACC_ZERO(acc)
        gemm_big<true>(acc, win + (size_t)col0 * 1024, 1024, xbf + (size_t)tok0 * 1024, 1024, 1024, smem);
        const bool kvrow = (tm == 63 || tm == 127 || tm == 128);
#pragma unroll
        for (int i = 0; i < TM; ++i)
#pragma unroll
            for (int j = 0; j < TN; ++j) {
                const int tok = tok0 + (wn * TN + j) * 16 + fr, col = col0 + (wm * TM + i) * 16 + 4 * fq;
                const f32x4 a = acc[i][j];
                store_bf4(proj + (size_t)tok * NPROJ + col, a[0], a[1], a[2], a[3]);
                if (tn == 2) {
                    const bool isk = col < OV;
                    const int cc = col - (isk ? OKK : OV);
                    if (kvrow) {
                        float* o;
                        if (tm == 128) o = P.out + (isk ? O_KS : O_VS) + ((size_t)l * 128 + (tok - TP)) * 128 + cc;
                        else o = P.out + (isk ? O_KP : O_VP) + (((size_t)l * 2 + (tm == 127 ? 1 : 0)) * 128 + (tok - tok0)) * 128 + cc;
                        *(f32x4*)o = a;
                    }
                    if (!isk && tm < 128) {
                        const int kvh = cc >> 6, d = cc & 63, n = tok >> 13, pos = tok & 8191;
                        u16* vp = vT + ((size_t)((n * 2 + kvh) * 64 + d)) * 8192 + pos;
#pragma unroll
                        for (int r = 0; r < 4; ++r) vp[(size_t)r * 8192] = f2bf(a[r]);
                    }
                }
            }
    }
}

__device__ void attn_item(const Params& P, int l, int item, unsigned char* smem) {
    const int tid = otid(), lane = tid & 63, wid = tid >> 6, fr = lane & 15, fq = lane >> 4;
    const int xcd_ = item & 7, s_ = (item >> 3) & 63, n = item >> 9;
    const int blk = xcd_ * 8 + (s_ >> 3), h = s_ & 7, kvh = h >> 2;
    u16* proj = (u16*)(P.ws + WS_PROJ);
    const u16* vT = (const u16*)(P.ws + WS_VT);
    u16* Ks = (u16*)smem;
    u16* VT = Ks + 256 * 72;
    const int kpos0 = (blk - 1) * 128;
    {
        uint4 kr[8], vr[8];
#pragma unroll
        for (int k = 0; k < 8; ++k) {
            const int i = tid + 256 * k;
            const int key = i >> 3, c8 = i & 7, pos = kpos0 + key, posc = pos < 0 ? 0 : pos;
            kr[k] = *(const uint4*)(proj + (size_t)(n * SEQL + posc) * NPROJ + OKK + kvh * 64 + c8 * 8);
            const int d = i >> 5, c = i & 31, vpos = kpos0 + c * 8, vposc = vpos < 0 ? 0 : vpos;
            vr[k] = *(const uint4*)(vT + ((size_t)((n * 2 + kvh) * 64 + d)) * 8192 + vposc);
        }
#pragma unroll
        for (int k = 0; k < 8; ++k) {
            const int i = tid + 256 * k;
            const int key = i >> 3, c8 = i & 7, pos = kpos0 + key;
            *(uint4*)(Ks + key * 72 + c8 * 8) = (pos >= 0) ? kr[k] : make_uint4(0, 0, 0, 0);
            const int d = i >> 5, c = i & 31, vpos = kpos0 + c * 8;
            *(uint4*)(VT + d * 264 + c * 8) = (vpos >= 0) ? vr[k] : make_uint4(0, 0, 0, 0);
        }
    }
    const int q0 = blk * 128 + wid * 32;
    const float slope = exp2f(-(float)(h + 1)), sink = P.in[7][l * 8 + h];
    bf16x8 qfa[2][2];
    uint2 zza[2][4];
#pragma unroll
    for (int nt = 0; nt < 2; ++nt) {
        const u16* rp = proj + (size_t)(n * SEQL + q0 + nt * 16 + fr) * NPROJ;
#pragma unroll
        for (int ks = 0; ks < 2; ++ks) qfa[nt][ks] = *(const bf16x8*)(rp + OQ + h * 64 + ks * 32 + fq * 8);
#pragma unroll
        for (int dt = 0; dt < 4; ++dt) zza[nt][dt] = *(const uint2*)(rp + OZA + h * 64 + dt * 16 + 4 * fq);
    }
    __syncthreads();
#pragma unroll
    for (int nt = 0; nt < 2; ++nt) {
        u16* rowp = proj + (size_t)(n * SEQL + q0 + nt * 16 + fr) * NPROJ;
        bf16x8 qf[2];
#pragma unroll
        for (int ks = 0; ks < 2; ++ks) qf[ks] = qfa[nt][ks];
        f32x4 st[10];
#pragma unroll
        for (int kt = 0; kt < 10; ++kt) {
            st[kt] = (f32x4){0.f, 0.f, 0.f, 0.f};
#pragma unroll
            for (int ks = 0; ks < 2; ++ks) {
                const bf16x8 kf = *(const bf16x8*)(Ks + (wid * 32 + kt * 16 + fr) * 72 + ks * 32 + fq * 8);
                st[kt] = mfma32(kf, qf[ks], st[kt]);
            }
        }
        const int qi = wid * 32 + nt * 16 + fr;
        float mx = sink;
#pragma unroll
        for (int kt = 0; kt < 10; ++kt)
#pragma unroll
            for (int r = 0; r < 4; ++r) {
                const int kk = wid * 32 + kt * 16 + 4 * fq + r, dist = 128 + qi - kk;
                const bool valid = (dist >= 0) && (dist <= 128) && (blk > 0 || kk >= 128);
                const float s = valid ? (st[kt][r] * 0.125f - slope * (float)dist) : -1e30f;
                st[kt][r] = s; mx = fmaxf(mx, s);
            }
        mx = fmaxf(mx, __shfl_xor(mx, 16)); mx = fmaxf(mx, __shfl_xor(mx, 32));
        float sum = 0.f;
#pragma unroll
        for (int kt = 0; kt < 10; ++kt)
#pragma unroll
            for (int r = 0; r < 4; ++r) { const float p = __expf(st[kt][r] - mx); st[kt][r] = p; sum += p; }
        sum += __shfl_xor(sum, 16); sum += __shfl_xor(sum, 32);
        const float inv = 1.0f / (sum + __expf(sink - mx));
        f32x4 o[4];
#pragma unroll
        for (int dt = 0; dt < 4; ++dt) o[dt] = (f32x4){0.f, 0.f, 0.f, 0.f};
#pragma unroll
        for (int kt = 0; kt < 10; ++kt) {
            const unsigned w0 = cvt_pk_bf16(st[kt][0] * inv, st[kt][1] * inv), w1 = cvt_pk_bf16(st[kt][2] * inv, st[kt][3] * inv);
            const bf16x4 pf = (bf16x4){(short)(w0 & 0xffff), (short)(w0 >> 16), (short)(w1 & 0xffff), (short)(w1 >> 16)};
#pragma unroll
            for (int dt = 0; dt < 4; ++dt) {
                const bf16x4 vf = *(const bf16x4*)(VT + (dt * 16 + fr) * 264 + wid * 32 + kt * 16 + 4 * fq);
                o[dt] = mfma16(vf, pf, o[dt]);
            }
        }
        uint2 zz[4];
#pragma unroll
        for (int dt = 0; dt < 4; ++dt) zz[dt] = zza[nt][dt];
#pragma unroll
        for (int dt = 0; dt < 4; ++dt) {
            const int d = h * 64 + dt * 16 + 4 * fq;
            const uint2 z = zz[dt];
            store_bf4(rowp + OQ + d, o[dt][0] * siluf_(bflo(z.x)), o[dt][1] * siluf_(bfhi(z.x)),
                      o[dt][2] * siluf_(bflo(z.y)), o[dt][3] * siluf_(bfhi(z.y)));
        }
    }
    __syncthreads();
}

__device__ void sgu_item(const Params& P, int l, int item, unsigned char* smem) {
    const int tid = otid(), lane = tid & 63, wid = tid >> 6, fr = lane & 15, fq = lane >> 4;
    const int g = (item >> 3) & 3, c = (item & 7) * 16 + (item >> 5);
    u16* proj = (u16*)(P.ws + WS_PROJ);
    const u16* sguw = (const u16*)(P.ws + WS_SGUW);
    u16* VnT = (u16*)smem;
    float* stat = (float*)(smem + 128 * 136 * 2);
    const size_t row0 = (size_t)c * 128;
    bf16x8 wfa[4][2];
#pragma unroll
    for (int ks = 0; ks < 4; ++ks)
#pragma unroll
        for (int tt = 0; tt < 2; ++tt) wfa[ks][tt] = *(const bf16x8*)(sguw + ((size_t)((l * 4 + g) * 128 + wid * 32 + tt * 16 + fr)) * 128 + ks * 32 + fq * 8);
    {
        const int q4 = lane >> 4, r16 = lane & 15;
#pragma unroll 1
        for (int ps = 0; ps < 8; ps += 4) {
            uint4 raw[4][4];
#pragma unroll
            for (int pp = 0; pp < 4; ++pp) {
                const int s_ = wid * 32 + (ps + pp) * 4 + q4;
#pragma unroll
                for (int c = 0; c < 4; ++c) raw[pp][c] = *(const uint4*)(proj + (row0 + s_) * NPROJ + OVC + r16 * 32 + c * 8);
            }
#pragma unroll
            for (int pp = 0; pp < 4; ++pp) {
                const int s_ = wid * 32 + (ps + pp) * 4 + q4;
                float sum = 0.f, sq = 0.f;
#pragma unroll
                for (int c = 0; c < 4; ++c) {
                    const uint4 w = raw[pp][c];
                    const float v[8] = {bflo(w.x), bfhi(w.x), bflo(w.y), bfhi(w.y), bflo(w.z), bfhi(w.z), bflo(w.w), bfhi(w.w)};
#pragma unroll
                    for (int e = 0; e < 8; ++e) { sum += v[e]; sq += v[e] * v[e]; }
                }
#pragma unroll
                for (int o = 1; o < 16; o <<= 1) { sum += __shfl_xor(sum, o); sq += __shfl_xor(sq, o); }
                const float mean = sum * (1.0f / 512.0f);
                const float var = fmaxf(sq * (1.0f / 512.0f) - mean * mean, 0.f);
                if (r16 == 0) { stat[2 * s_] = mean; stat[2 * s_ + 1] = rsqrtf(var + 1e-5f); }
            }
        }
    }
    __syncthreads();
    {
        const int s = tid & 127, half = tid >> 7;
        const float mean = stat[2 * s], rstd = stat[2 * s + 1];
        const u16* src = proj + (row0 + s) * NPROJ + OVC + g * 128 + half * 64;
        const float* lng = P.in[18] + l * 512 + g * 128 + half * 64;
        const float* lnb = P.in[19] + l * 512 + g * 128 + half * 64;
#pragma unroll
        for (int c8 = 0; c8 < 8; ++c8) {
            const uint4 raw = *(const uint4*)(src + c8 * 8);
            const float v[8] = {bflo(raw.x), bfhi(raw.x), bflo(raw.y), bfhi(raw.y), bflo(raw.z), bfhi(raw.z), bflo(raw.w), bfhi(raw.w)};
            const float4 g0 = *(const float4*)(lng + c8 * 8), g1 = *(const float4*)(lng + c8 * 8 + 4), b0 = *(const float4*)(lnb + c8 * 8), b1 = *(const float4*)(lnb + c8 * 8 + 4);
            const float gg[8] = {g0.x, g0.y, g0.z, g0.w, g1.x, g1.y, g1.z, g1.w}, bb[8] = {b0.x, b0.y, b0.z, b0.w, b1.x, b1.y, b1.z, b1.w};
#pragma unroll
            for (int e = 0; e < 8; ++e) {
                const int w = c8 * 8 + e;
                VnT[(half * 64 + w) * 136 + s] = f2bf((v[e] - mean) * rstd * gg[e] + bb[e]);
            }
        }
    }
    __syncthreads();
    f32x4 acc[8][2];
#pragma unroll
    for (int wt = 0; wt < 8; ++wt) { acc[wt][0] = (f32x4){0.f, 0.f, 0.f, 0.f}; acc[wt][1] = (f32x4){0.f, 0.f, 0.f, 0.f}; }
    uint2 uu[2][8], zz[2][8];
    float biasv[2];
#pragma unroll
    for (int tt = 0; tt < 2; ++tt) {
        const int t = wid * 32 + tt * 16 + fr;
        biasv[tt] = P.in[21][(l * 4 + g) * 128 + t];
        const u16* rowp = proj + (row0 + t) * NPROJ;
#pragma unroll
        for (int wt = 0; wt < 8; ++wt) { const int w = g * 128 + wt * 16 + 4 * fq; uu[tt][wt] = *(const uint2*)(rowp + OUC + w); zz[tt][wt] = *(const uint2*)(rowp + OZC + w); }
    }
#pragma unroll
    for (int ks = 0; ks < 4; ++ks) {
        if (ks <= wid) {
#pragma unroll
            for (int wt = 0; wt < 8; ++wt) {
                const bf16x8 vf = *(const bf16x8*)(VnT + (wt * 16 + fr) * 136 + ks * 32 + fq * 8);
                acc[wt][0] = mfma32(vf, wfa[ks][0], acc[wt][0]);
                acc[wt][1] = mfma32(vf, wfa[ks][1], acc[wt][1]);
            }
        }
    }
#pragma unroll
    for (int tt = 0; tt < 2; ++tt) {
        const int t = wid * 32 + tt * 16 + fr;
        const float bias = biasv[tt];
        u16* rowp = proj + (row0 + t) * NPROJ;
#pragma unroll
        for (int wt = 0; wt < 8; ++wt) {
            const int w = g * 128 + wt * 16 + 4 * fq;
            const uint2 u = uu[tt][wt], z = zz[tt][wt];
            const f32x4 a = acc[wt][tt];
            store_bf4(rowp + OUC + w, bflo(u.x) * (a[0] + bias) * siluf_(bflo(z.x)), bfhi(u.x) * (a[1] + bias) * siluf_(bfhi(z.x)),
                      bflo(u.y) * (a[2] + bias) * siluf_(bflo(z.y)), bfhi(u.y) * (a[3] + bias) * siluf_(bfhi(z.y)));
        }
    }
    __syncthreads();
}

template <bool FULL>
__device__ void s5_item(const Params& P, int l, int item, unsigned char* smem) {
    const int tid = otid(), lane = tid & 63, wid = tid >> 6, fr = lane & 15, fq = lane >> 4;
    const int tau = item * 4 + wid, g = tau & 31, c = tau >> 5;
    float* xs = (float*)smem + wid * (16 * 132);
    u16* hs = (u16*)(smem + 4 * 16 * 132 * 4) + wid * (16 * 136);
    u16* proj = (u16*)(P.ws + WS_PROJ);
    const float* abar = (const float*)(P.ws + WS_ABAR) + (size_t)((l * 32 + g) * 64 + lane) * 2;
    const float ar = abar[0], ai = abar[1];
    const u16* bbt = (const u16*)(P.ws + WS_BBT) + (size_t)(l * 32 + g) * 128 * 16;
    bf16x4 bfrag[8];
#pragma unroll
    for (int nt = 0; nt < 8; ++nt) bfrag[nt] = *(const bf16x4*)(bbt + (nt * 16 + fr) * 16 + 4 * fq);
    bf16x8 cfrag[4];
    float dsk[4];
    if (FULL) {
        const u16* cmt = (const u16*)(P.ws + WS_CMT) + (size_t)(l * 32 + g) * 16 * 128;
#pragma unroll
        for (int ks = 0; ks < 4; ++ks) cfrag[ks] = *(const bf16x8*)(cmt + fr * 128 + ks * 32 + fq * 8);
#pragma unroll
        for (int r = 0; r < 4; ++r) dsk[r] = P.in[15][l * 512 + g * 16 + 4 * fq + r];
    }
    float* sst = (float*)(P.ws + WS_SST);
    float hr = 0.f, hi = 0.f;
    if (FULL) {
        const int cl = c & 63;
        const float* a128 = (const float*)(P.ws + WS_A128) + (size_t)((l * 32 + g) * 64 + lane) * 2;
        const float Ar = a128[0], Ai = a128[1];
        const float* S = sst + ((size_t)(c - cl) * 32 + g) * 128;
        int j = 0;
        for (; j + 32 <= cl; j += 32) {
            float sr[32], si[32];
#pragma unroll
            for (int k = 0; k < 32; ++k) { sr[k] = S[(size_t)(j + k) * 4096 + lane]; si[k] = S[(size_t)(j + k) * 4096 + 64 + lane]; }
#pragma unroll
            for (int k = 0; k < 32; ++k) { const float nr = Ar * hr - Ai * hi + sr[k]; hi = Ar * hi + Ai * hr + si[k]; hr = nr; }
        }
        for (; j + 8 <= cl; j += 8) {
            float sr[8], si[8];
#pragma unroll
            for (int k = 0; k < 8; ++k) { sr[k] = S[(size_t)(j + k) * 4096 + lane]; si[k] = S[(size_t)(j + k) * 4096 + 64 + lane]; }
#pragma unroll
            for (int k = 0; k < 8; ++k) { const float nr = Ar * hr - Ai * hi + sr[k]; hi = Ar * hi + Ai * hr + si[k]; hr = nr; }
        }
        for (; j < cl; ++j) {
            const float sr = S[(size_t)j * 4096 + lane], si = S[(size_t)j * 4096 + 64 + lane];
            const float nr = Ar * hr - Ai * hi + sr; hi = Ar * hi + Ai * hr + si; hr = nr;
        }
    }
    u16* ub = proj + (size_t)(c * 128) * NPROJ + OUB + g * 16 + 4 * fq;
    bf16x4 ufs[8];
#pragma unroll
    for (int sc = 0; sc < 8; ++sc) ufs[sc] = *(const bf16x4*)(ub + (size_t)(sc * 16 + fr) * NPROJ);
#pragma unroll
    for (int sc = 0; sc < 8; ++sc) {
        u16* up = ub + (size_t)(sc * 16 + fr) * NPROJ;
        const bf16x4 uf = ufs[sc];
#pragma unroll
        for (int nt = 0; nt < 8; ++nt) {
            const f32x4 x = mfma16(uf, bfrag[nt], (f32x4){0.f, 0.f, 0.f, 0.f});
#pragma unroll
            for (int r = 0; r < 4; ++r) xs[(4 * fq + r) * 132 + nt * 16 + fr] = x[r];
        }
        __syncthreads();
        float xrv[16], xiv[16];
#pragma unroll
        for (int t = 0; t < 16; ++t) { xrv[t] = xs[t * 132 + lane]; xiv[t] = xs[t * 132 + 64 + lane]; }
#pragma unroll
        for (int t = 0; t < 16; ++t) {
            const float xr = xrv[t], xi = xiv[t];
            const float nr = ar * hr - ai * hi + xr; hi = ar * hi + ai * hr + xi; hr = nr;
            if (FULL) { hs[t * 136 + lane] = f2bf(hr); hs[t * 136 + 64 + lane] = f2bf(hi); }
        }
        __syncthreads();
        if (FULL) {
            f32x4 y = (f32x4){0.f, 0.f, 0.f, 0.f};
#pragma unroll
            for (int ks = 0; ks < 4; ++ks) {
                const bf16x8 hf = *(const bf16x8*)(hs + fr * 136 + ks * 32 + fq * 8);
                y = mfma32(cfrag[ks], hf, y);
            }
            float o[4];
#pragma unroll
            for (int r = 0; r < 4; ++r) o[r] = geluf_(y[r] + dsk[r] * bf2f((u16)uf[r]));
            store_bf4(up, o[0], o[1], o[2], o[3]);
        }
    }
    if (!FULL) { float* S = sst + ((size_t)c * 32 + g) * 128; S[lane] = hr; S[64 + lane] = hi; }
    else if ((c & 63) == 63) {
        const size_t o = ((size_t)(l * 2 + (c >> 6)) * 32 + g) * 64 + lane;
        P.out[O_HRP + o] = hr; P.out[O_HIP + o] = hi;
    }
    __syncthreads();
}

__device__ void sample_item(const Params& P, int l, int b, int part, unsigned char* smem) {
    const int tid = otid(), lane = tid & 63, wid = tid >> 6;
    u16* prow = (u16*)(P.ws + WS_PROJ) + (size_t)(TP + b) * NPROJ;
    float* row = (float*)smem;
    float* sc = row + 3840;
    float* red = sc + 8 * 132;
    float* hst = red + 64;
    if (part == 0) {
        if (tid < 160) {
            const uint4 raw = *(const uint4*)(prow + tid * 8);
            float* r = row + tid * 8;
            r[0] = bflo(raw.x); r[1] = bfhi(raw.x); r[2] = bflo(raw.y); r[3] = bfhi(raw.y); r[4] = bflo(raw.z); r[5] = bfhi(raw.z); r[6] = bflo(raw.w); r[7] = bfhi(raw.w);
        }
        __syncthreads();
        {
            const int j = tid & 127, kvh = tid >> 7;
            const float* ck = P.in[2] + (((size_t)l * 128 + b) * 128 + j) * 128 + kvh * 64;
            float4 kk[16];
#pragma unroll
            for (int d = 0; d < 16; ++d) { const f32x4 t_ = __builtin_nontemporal_load((const f32x4*)(ck + 4 * d)); kk[d] = make_float4(t_[0], t_[1], t_[2], t_[3]); }
            const float* q = row + OQ + kvh * 256;
            float d0 = 0.f, d1 = 0.f, d2 = 0.f, d3 = 0.f;
#pragma unroll
            for (int d4 = 0; d4 < 16; ++d4) {
                const int d = 4 * d4; const float4 k4 = kk[d4];
                d0 += q[d] * k4.x + q[d + 1] * k4.y + q[d + 2] * k4.z + q[d + 3] * k4.w;
                d1 += q[64 + d] * k4.x + q[64 + d + 1] * k4.y + q[64 + d + 2] * k4.z + q[64 + d + 3] * k4.w;
                d2 += q[128 + d] * k4.x + q[128 + d + 1] * k4.y + q[128 + d + 2] * k4.z + q[128 + d + 3] * k4.w;
                d3 += q[192 + d] * k4.x + q[192 + d + 1] * k4.y + q[192 + d + 2] * k4.z + q[192 + d + 3] * k4.w;
            }
            const float dist = (float)(128 - j);
            const int h0 = kvh * 4;
            sc[(h0 + 0) * 132 + j] = d0 * 0.125f - exp2f(-(float)(h0 + 1)) * dist;
            sc[(h0 + 1) * 132 + j] = d1 * 0.125f - exp2f(-(float)(h0 + 2)) * dist;
            sc[(h0 + 2) * 132 + j] = d2 * 0.125f - exp2f(-(float)(h0 + 3)) * dist;
            sc[(h0 + 3) * 132 + j] = d3 * 0.125f - exp2f(-(float)(h0 + 4)) * dist;
            if (tid < 8) {
                const int h = tid;
                const float* qq = row + OQ + h * 64; const float* k2 = row + OKK + (h >> 2) * 64;
                float d = 0.f;
                for (int e = 0; e < 64; ++e) d += qq[e] * k2[e];
                sc[h * 132 + 128] = d * 0.125f;
            }
        }
        __syncthreads();
#pragma unroll
        for (int hh = 0; hh < 2; ++hh) {
            const int h = wid * 2 + hh;
            const float sink = P.in[7][l * 8 + h];
            const float s0 = sc[h * 132 + lane], s1 = sc[h * 132 + 64 + lane], s2 = (lane == 0) ? sc[h * 132 + 128] : -1e30f;
            const float mx = fmaxf(wave_max(fmaxf(fmaxf(s0, s1), s2)), sink);
            const float e0 = __expf(s0 - mx), e1 = __expf(s1 - mx), e2 = (lane == 0) ? __expf(s2 - mx) : 0.f;
            const float inv = 1.0f / (wave_sum(e0 + e1 + e2) + __expf(sink - mx));
            sc[h * 132 + lane] = e0 * inv; sc[h * 132 + 64 + lane] = e1 * inv;
            if (lane == 0) sc[h * 132 + 128] = e2 * inv;
        }
        __syncthreads();
        {
            const int d = tid & 63, jq = (tid >> 6) & 1, kvh = tid >> 7;
            const float* cv = P.in[3] + (((size_t)l * 128 + b) * 128 + jq * 64) * 128 + kvh * 64 + d;
            const float* p = sc + (kvh * 4) * 132 + jq * 64;
            float a0 = 0.f, a1 = 0.f, a2 = 0.f, a3 = 0.f;
#pragma unroll
            for (int jb = 0; jb < 64; jb += 32) {
                float vv[32];
#pragma unroll
                for (int j = 0; j < 32; ++j) vv[j] = __builtin_nontemporal_load(&cv[(size_t)(jb + j) * 128]);
#pragma unroll
                for (int j = 0; j < 32; ++j) { a0 += p[jb + j] * vv[j]; a1 += p[132 + jb + j] * vv[j]; a2 += p[264 + jb + j] * vv[j]; a3 += p[396 + jb + j] * vv[j]; }
            }
            float* pp = hst + ((kvh * 2 + jq) * 4) * 64 + d;
            pp[0] = a0; pp[64] = a1; pp[128] = a2; pp[192] = a3;
        }
        __syncthreads();
#pragma unroll
        for (int rep = 0; rep < 2; ++rep) {
            const int idx = tid + rep * 256, h = idx >> 6, d = idx & 63, kvh = h >> 2, hh = h & 3;
            const float acc = hst[((kvh * 2 + 0) * 4 + hh) * 64 + d] + hst[((kvh * 2 + 1) * 4 + hh) * 64 + d] + sc[h * 132 + 128] * row[OV + kvh * 64 + d];
            prow[OQ + idx] = f2bf(acc * siluf_(row[OZA + idx]));
        }
    } else {
        {
            const int c = (tid < 64) ? (OUB + tid * 8) : (OUC + (tid - 64) * 8);
            const uint4 raw = *(const uint4*)(prow + c);
            float* r = row + c;
            r[0] = bflo(raw.x); r[1] = bfhi(raw.x); r[2] = bflo(raw.y); r[3] = bfhi(raw.y); r[4] = bflo(raw.z); r[5] = bfhi(raw.z); r[6] = bflo(raw.w); r[7] = bfhi(raw.w);
        }
        __syncthreads();
        {
            const int p = lane;
            const float* abar = (const float*)(P.ws + WS_ABAR);
#pragma unroll
            for (int gi = 0; gi < 8; ++gi) {
                const int g = wid + 4 * gi;
                const u16* bb = (const u16*)(P.ws + WS_BBT) + (size_t)(l * 32 + g) * 128 * 16;
                const uint4 r0 = *(const uint4*)(bb + p * 16), r1 = *(const uint4*)(bb + p * 16 + 8);
                const uint4 i0 = *(const uint4*)(bb + (64 + p) * 16), i1 = *(const uint4*)(bb + (64 + p) * 16 + 8);
                const float* u = row + OUB + g * 16;
                const float xr = bflo(r0.x) * u[0] + bfhi(r0.x) * u[1] + bflo(r0.y) * u[2] + bfhi(r0.y) * u[3] + bflo(r0.z) * u[4] + bfhi(r0.z) * u[5] + bflo(r0.w) * u[6] + bfhi(r0.w) * u[7]
                               + bflo(r1.x) * u[8] + bfhi(r1.x) * u[9] + bflo(r1.y) * u[10] + bfhi(r1.y) * u[11] + bflo(r1.z) * u[12] + bfhi(r1.z) * u[13] + bflo(r1.w) * u[14] + bfhi(r1.w) * u[15];
                const float xi = bflo(i0.x) * u[0] + bfhi(i0.x) * u[1] + bflo(i0.y) * u[2] + bfhi(i0.y) * u[3] + bflo(i0.z) * u[4] + bfhi(i0.z) * u[5] + bflo(i0.w) * u[6] + bfhi(i0.w) * u[7]
                               + bflo(i1.x) * u[8] + bfhi(i1.x) * u[9] + bflo(i1.y) * u[10] + bfhi(i1.y) * u[11] + bflo(i1.z) * u[12] + bfhi(i1.z) * u[13] + bflo(i1.w) * u[14] + bfhi(i1.w) * u[15];
                const size_t si = (((size_t)l * 128 + b) * 32 + g) * 64 + p;
                const float h0r = P.in[4][si], h0i = P.in[5][si];
                const float ar = abar[((l * 32 + g) * 64 + p) * 2], ai = abar[((l * 32 + g) * 64 + p) * 2 + 1];
                const float hr = ar * h0r - ai * h0i + xr, hi = ar * h0i + ai * h0r + xi;
                P.out[O_HRS + si] = hr; P.out[O_HIS + si] = hi;
                hst[g * 128 + p] = hr; hst[g * 128 + 64 + p] = hi;
            }
        }
        __syncthreads();
#pragma unroll
        for (int rep = 0; rep < 2; ++rep) {
            const int ch = tid + rep * 256, g = ch >> 4, ho = ch & 15;
            const float* cre = P.in[13] + ((size_t)(l * 32 + g) * 16 + ho) * 64;
            const float* cim = P.in[14] + ((size_t)(l * 32 + g) * 16 + ho) * 64;
            float4 cr[16], ci[16];
#pragma unroll
            for (int k = 0; k < 16; ++k) { cr[k] = *(const float4*)(cre + 4 * k); ci[k] = *(const float4*)(cim + 4 * k); }
            const float* hh = hst + g * 128;
            float acc = 0.f;
#pragma unroll
            for (int k = 0; k < 16; ++k) {
                const int p = 4 * k;
                acc += hh[p] * cr[k].x - hh[64 + p] * ci[k].x + hh[p + 1] * cr[k].y - hh[64 + p + 1] * ci[k].y
                     + hh[p + 2] * cr[k].z - hh[64 + p + 2] * ci[k].z + hh[p + 3] * cr[k].w - hh[64 + p + 3] * ci[k].w;
            }
            const float y = acc + P.in[15][l * 512 + ch] * row[OUB + ch];
            prow[OUB + ch] = f2bf(geluf_(y));
        }
        {
            const float v0 = row[OVC + tid], v1 = row[OVC + 256 + tid];
            float s_ = wave_sum(v0 + v1);
            if (lane == 0) red[wid] = s_;
            __syncthreads();
            const float mean = (red[0] + red[1] + red[2] + red[3]) * (1.0f / 512.0f);
            const float e0 = v0 - mean, e1 = v1 - mean;
            float q = wave_sum(e0 * e0 + e1 * e1);
            if (lane == 0) red[8 + wid] = q;
            __syncthreads();
            const float rstd = rsqrtf((red[8] + red[9] + red[10] + red[11]) * (1.0f / 512.0f) + 1e-5f);
#pragma unroll
            for (int rep = 0; rep < 2; ++rep) {
                const int ch = tid + rep * 256, g = ch >> 7;
                const float vn = (rep ? e1 : e0) * rstd * P.in[18][l * 512 + ch] + P.in[19][l * 512 + ch];
                P.out[O_VC + ((size_t)l * 128 + b) * 512 + ch] = vn;
                const float sg = P.in[20][(size_t)(l * 4 + g) * 128 * 128] * vn + P.in[21][(l * 4 + g) * 128];
                prow[OUC + ch] = f2bf(row[OUC + ch] * sg * siluf_(row[OZC + ch]));
            }
        }
    }
    __syncthreads();
}

__device__ __forceinline__ u16* gate_ptr(const Params& P, int b, int tok, int c) {
    if (b == 0) return (u16*)(P.ws + WS_MRG) + (size_t)tok * 1024 + c;
    if (b == 1) return (c < 768) ? ((u16*)(P.ws + WS_PROJ) + (size_t)tok * NPROJ + 512 + c) : ((u16*)(P.ws + WS_GX) + (size_t)tok * 256 + (c - 768));
    return (u16*)(P.ws + WS_PROJ) + (size_t)tok * NPROJ + 2816 + c;
}
template <int TM, int TN, int WM, int WN>
__device__ __forceinline__ void gate_tile(const Params& P, int l, int tok0, int gcol0, unsigned char* smem) {
    TILE_IDS
    const u16* xbf = (const u16*)(P.ws + WS_XBF);
    const u16* win = (const u16*)(P.ws + WS_WIN) + (size_t)l * NIN * 1024;
    f32x4 acc[TM][TN];
    ACC_ZERO(acc)
    gemm_any<TM, TN, WM, WN, true>(acc, win, OG + gcol0, 1024, xbf + (size_t)tok0 * 1024, 1024, 1024, smem);
    const int b = gcol0 >> 10;
#pragma unroll
    for (int i = 0; i < TM; ++i)
#pragma unroll
        for (int j = 0; j < TN; ++j) {
            const int tok = tok0 + (wn * TN + j) * 16 + fr, c = (gcol0 & 1023) + (wm * TM + i) * 16 + 4 * fq;
            const f32x4 a = acc[i][j];
            store_bf4(gate_ptr(P, b, tok, c), sigmoidf_(a[0]), sigmoidf_(a[1]), sigmoidf_(a[2]), sigmoidf_(a[3]));
        }
}
__device__ void phase2(const Params& P, int l, unsigned char* smem) {
    const bool gemm_first = blockIdx.x < (gridDim.x >> 1);
#pragma unroll 1
    for (int pass = 0; pass < 2; ++pass) {
        if ((pass == 0) == gemm_first) {
            XCD_TILE_LOOP(q, 512) gate_tile<8, 4, 2, 2>(P, l, (q >> 2) * 128, (q & 3) * 256, smem);
        } else {
            for (int it = blockIdx.x; it < 2816; it += gridDim.x) {
                if (it < 1024) attn_item(P, l, it, smem);
                else if (it < 1536) sgu_item(P, l, it - 1024, smem);
                else if (it < 1792) sample_item(P, l, (it - 1536) & 127, (it - 1536) >> 7, smem);
                else s5_item<false>(P, l, it - 1792, smem);
            }
        }
    }
}
__device__ void phase3(const Params& P, int l, unsigned char* smem) {
    XCD_TILE_LOOP(q, 1024) gate_tile<8, 4, 2, 2>(P, l, ((q & 511) >> 2) * 128, 1024 + (q >> 9) * 1024 + (q & 3) * 256, smem);
    for (int it = blockIdx.x; it < 1024 + 192; it += gridDim.x) {
        if (it < 1024) s5_item<true>(P, l, it, smem);
        else gate_tile<1, 2, 1, 4>(P, l, TP, (it - 1024) * 16, smem);
    }
}

template <int TM, int TN, int WM, int WN>
__device__ __forceinline__ void glu_tile(const Params& P, int l, int tok0, int col0, unsigned char* smem) {
    TILE_IDS
    u16* proj = (u16*)(P.ws + WS_PROJ);
    const u16* gw = (const u16*)(P.ws + WS_GLU) + (size_t)l * 512 * 512;
    f32x4 acc[TM][TN];
    ACC_ZERO(acc)
    gemm_accum<TM, TN, WM, WN>(acc, gw + (size_t)col0 * 512, 512, proj + (size_t)tok0 * NPROJ + OUB, NPROJ, 512, (u16*)smem);
    uint2 yy[TM][TN], zz[TM][TN];
    f32x4 gbv[TM];
#pragma unroll
    for (int i = 0; i < TM; ++i) {
        gbv[i] = *(const f32x4*)(P.in[17] + l * 512 + col0 + (wm * TM + i) * 16 + 4 * fq);
#pragma unroll
        for (int j = 0; j < TN; ++j) {
            const int tok = tok0 + (wn * TN + j) * 16 + fr, col = col0 + (wm * TM + i) * 16 + 4 * fq;
            const u16* rowp = proj + (size_t)tok * NPROJ;
            yy[i][j] = *(const uint2*)(rowp + OUB + col); zz[i][j] = *(const uint2*)(rowp + OZB + col);
        }
    }
#pragma unroll
    for (int i = 0; i < TM; ++i)
#pragma unroll
        for (int j = 0; j < TN; ++j) {
            const int tok = tok0 + (wn * TN + j) * 16 + fr, col = col0 + (wm * TM + i) * 16 + 4 * fq;
            const f32x4 gb = gbv[i];
            u16* rowp = proj + (size_t)tok * NPROJ;
            const uint2 y = yy[i][j], z = zz[i][j];
            const f32x4 a = acc[i][j];
            store_bf4(rowp + OZB + col, bflo(y.x) * sigmoidf_(a[0] + gb[0]) * siluf_(bflo(z.x)), bfhi(y.x) * sigmoidf_(a[1] + gb[1]) * siluf_(bfhi(z.x)),
                      bflo(y.y) * sigmoidf_(a[2] + gb[2]) * siluf_(bflo(z.y)), bfhi(y.y) * sigmoidf_(a[3] + gb[3]) * siluf_(bfhi(z.y)));
        }
}
__device__ void phase4(const Params& P, int l, unsigned char* smem) {
    for (int it = blockIdx.x; it < 32; it += gridDim.x) glu_tile<1, 2, 1, 4>(P, l, TP, it * 16, smem);
    XCD_TILE_LOOP(id, 512) glu_tile<4, 4, 2, 2>(P, l, (id >> 2) * 128, (id & 3) * 128, smem);
}

template <int TM, int TN, int WM, int WN>
__device__ __forceinline__ void merge_tile(const Params& P, int l, int tok0, int col0, unsigned char* smem) {
    TILE_IDS
    const u16* proj = (const u16*)(P.ws + WS_PROJ);
    const u16* wr = (const u16*)(P.ws + WS_WR) + (size_t)l * 3 * 1024 * 512;
    u16* mrg = (u16*)(P.ws + WS_MRG);
#pragma unroll 1
    for (int b = 0; b < 3; ++b) {
        f32x4 acc[TM][TN];
        ACC_ZERO(acc)
        const int yoff = (b == 0) ? OQ : ((b == 1) ? OZB : OUC);
        gemm_any<TM, TN, WM, WN>(acc, wr + (size_t)b * 1024 * 512, col0, 512, proj + (size_t)tok0 * NPROJ + yoff, NPROJ, 512, smem);
        const u16* gbase; int gstride;
        if (b == 0) { gbase = mrg + col0; gstride = 1024; }
        else if (b == 1) { if (col0 < 768) { gbase = proj + 512 + col0; gstride = NPROJ; } else { gbase = (const u16*)(P.ws + WS_GX) + (col0 - 768); gstride = 256; } }
        else { gbase = proj + 2816 + col0; gstride = NPROJ; }
        constexpr int IB = (TM >= 2) ? 2 : 1;
#pragma unroll
        for (int i0 = 0; i0 < TM; i0 += IB) {
            uint2 g[IB][TN], m[IB][TN];
#pragma unroll
            for (int ii = 0; ii < IB; ++ii)
#pragma unroll
                for (int j = 0; j < TN; ++j) {
                    const int tok = tok0 + (wn * TN + j) * 16 + fr, lc = (wm * TM + i0 + ii) * 16 + 4 * fq;
                    g[ii][j] = *(const uint2*)(gbase + (size_t)tok * gstride + lc);
                    m[ii][j] = make_uint2(0u, 0u);
                    if (b > 0) m[ii][j] = *(const uint2*)(mrg + (size_t)tok * 1024 + col0 + lc);
                }
#pragma unroll
            for (int ii = 0; ii < IB; ++ii)
#pragma unroll
                for (int j = 0; j < TN; ++j) {
                    const int tok = tok0 + (wn * TN + j) * 16 + fr, lc = (wm * TM + i0 + ii) * 16 + 4 * fq;
                    const f32x4 a = acc[i0 + ii][j];
                    store_bf4(mrg + (size_t)tok * 1024 + col0 + lc, bflo(m[ii][j].x) + bflo(g[ii][j].x) * a[0], bfhi(m[ii][j].x) + bfhi(g[ii][j].x) * a[1],
                              bflo(m[ii][j].y) + bflo(g[ii][j].y) * a[2], bfhi(m[ii][j].y) + bfhi(g[ii][j].y) * a[3]);
                }
            asm volatile("" ::: "memory");
        }
    }
}
__device__ void phase5(const Params& P, int l, unsigned char* smem) {
    for (int it = blockIdx.x; it < 64; it += gridDim.x) merge_tile<1, 2, 1, 4>(P, l, TP, it * 16, smem);
    XCD_TILE_LOOP(id, 512) merge_tile<8, 4, 2, 2>(P, l, (id >> 2) * 128, (id & 3) * 256, smem);
}

template <int TM, int TN, int WM, int WN>
__device__ __forceinline__ void oproj_tile(const Params& P, int l, int tok0, int col0, unsigned char* smem) {
    TILE_IDS
    const u16* mrg = (const u16*)(P.ws + WS_MRG);
    const u16* wo = (const u16*)(P.ws + WS_WO) + (size_t)l * 1024 * 1024;
    f32x4 acc[TM][TN];
    ACC_ZERO(acc)
    gemm_any<TM, TN, WM, WN>(acc, wo, col0, 1024, mrg + (size_t)tok0 * 1024, 1024, 1024, smem);
    constexpr int IB = (TM >= 2) ? 2 : 1;
#pragma unroll
    for (int i0 = 0; i0 < TM; i0 += IB) {
        f32x4 xr[IB][TN];
#pragma unroll
        for (int ii = 0; ii < IB; ++ii)
#pragma unroll
            for (int j = 0; j < TN; ++j) {
                const int tok = tok0 + (wn * TN + j) * 16 + fr, col = col0 + (wm * TM + i0 + ii) * 16 + 4 * fq;
                const float* res = (l == 0) ? ((tok < TP) ? (P.in[0] + (size_t)tok * 1024 + col) : (P.in[1] + (size_t)(tok - TP) * 1024 + col))
                                            : (P.out + (size_t)tok * 1024 + col);
                xr[ii][j] = __builtin_nontemporal_load((const f32x4*)res);
            }
#pragma unroll
        for (int ii = 0; ii < IB; ++ii)
#pragma unroll
            for (int j = 0; j < TN; ++j) {
                const int tok = tok0 + (wn * TN + j) * 16 + fr, col = col0 + (wm * TM + i0 + ii) * 16 + 4 * fq;
                *(f32x4*)(P.out + (size_t)tok * 1024 + col) = xr[ii][j] * ALPHA_C + acc[i0 + ii][j];
            }
        asm volatile("" ::: "memory");
    }
}
__device__ void phase6(const Params& P, int l, unsigned char* smem) {
    for (int it = blockIdx.x; it < 64; it += gridDim.x) oproj_tile<1, 2, 1, 4>(P, l, TP, it * 16, smem);
    XCD_TILE_LOOP(id, 512) oproj_tile<8, 4, 2, 2>(P, l, (id >> 2) * 128, (id & 3) * 256, smem);
}

__device__ void phase7(const Params& P, int l) {
    const int tid = otid(), lane = tid & 63;
    const int gw = blockIdx.x * 4 + (tid >> 6), nw = gridDim.x * 4;
    u16* xbf = (u16*)(P.ws + WS_XBF);
    const float* g = P.in[24] + l * 1024; const float* bta = P.in[25] + l * 1024;
    for (int row0 = gw; row0 < TT; row0 += 2 * nw) {
        const int row1 = row0 + nw;
        const bool has1 = row1 < TT;
        float* xr0 = P.out + (size_t)row0 * 1024;
        float* xr1 = P.out + (size_t)(has1 ? row1 : row0) * 1024;
        f32x4 v0[4], v1[4];
#pragma unroll
        for (int i = 0; i < 4; ++i) { v0[i] = __builtin_nontemporal_load((const f32x4*)(xr0 + i * 256 + lane * 4)); v1[i] = __builtin_nontemporal_load((const f32x4*)(xr1 + i * 256 + lane * 4)); }
        float s0 = 0.f, s1 = 0.f;
#pragma unroll
        for (int i = 0; i < 4; ++i) { s0 += (v0[i][0] + v0[i][1]) + (v0[i][2] + v0[i][3]); s1 += (v1[i][0] + v1[i][1]) + (v1[i][2] + v1[i][3]); }
        const float m0 = wave_sum(s0) * (1.0f / 1024.0f), m1 = wave_sum(s1) * (1.0f / 1024.0f);
        float q0 = 0.f, q1 = 0.f;
#pragma unroll
        for (int i = 0; i < 4; ++i) {
            v0[i] = v0[i] - m0; q0 += (v0[i][0] * v0[i][0] + v0[i][1] * v0[i][1]) + (v0[i][2] * v0[i][2] + v0[i][3] * v0[i][3]);
            v1[i] = v1[i] - m1; q1 += (v1[i][0] * v1[i][0] + v1[i][1] * v1[i][1]) + (v1[i][2] * v1[i][2] + v1[i][3] * v1[i][3]);
        }
        const float r0 = rsqrtf(wave_sum(q0) * (1.0f / 1024.0f) + 1e-5f), r1 = rsqrtf(wave_sum(q1) * (1.0f / 1024.0f) + 1e-5f);
#pragma unroll
        for (int i = 0; i < 4; ++i) {
            const int c = i * 256 + lane * 4;
            const f32x4 gg = *(const f32x4*)(g + c), bb = *(const f32x4*)(bta + c);
            const f32x4 y0 = v0[i] * r0 * gg + bb, y1 = v1[i] * r1 * gg + bb;
            __builtin_nontemporal_store(y0, (f32x4*)(xr0 + c));
            if (l == 0) store_bf4(xbf + xt_ofs(row0, c), y0[0], y0[1], y0[2], y0[3]);
            if (has1) {
                __builtin_nontemporal_store(y1, (f32x4*)(xr1 + c));
                if (l == 0) store_bf4(xbf + xt_ofs(row1, c), y1[0], y1[1], y1[2], y1[3]);
            }
        }
    }
}

#define XB_TMO      128
#define XB_XCNT(j)  (256  + 64 * (j))
#define XB_XSUB(j)  (1280 + 64 * (j))
#define XB_XGEN(j)  (2304 + 64 * (j))
#define XB_TOP      3328
#define XB_TOPGEN   3392
#define XCD_BAR_WORDS 3456
#define XB_SPIN_CAP (1u << 18)
#define LAS __attribute__((address_space(3)))
__device__ __forceinline__ unsigned xb_ld(unsigned* p)              { return __hip_atomic_load(p, __ATOMIC_RELAXED, __HIP_MEMORY_SCOPE_AGENT); }
__device__ __forceinline__ unsigned xb_add(unsigned* p, unsigned v) { return __hip_atomic_fetch_add(p, v, __ATOMIC_RELAXED, __HIP_MEMORY_SCOPE_AGENT); }
__device__ __forceinline__ unsigned xb_xcc_id() { return (unsigned)__builtin_amdgcn_s_getreg((3 << 11) | 20) & 0xFu; }
#define XB_SPIN(cond, bar) do { unsigned _sp = 0; while (cond) { __builtin_amdgcn_s_sleep(1); \
    if ((++_sp & 255u) == 0u) { if (xb_ld(&(bar)[XB_TMO])) break; if (_sp > XB_SPIN_CAP) { atomicAdd(&(bar)[XB_TMO], 1u); break; } } } } while (0)
struct XcdBarrier { unsigned* bar; unsigned x; volatile LAS unsigned* st; };
__device__ __forceinline__ XcdBarrier xcd_barrier_post(unsigned* bar, volatile LAS unsigned* st) {
    XcdBarrier b; b.bar = bar; b.x = xb_xcc_id(); b.st = st;
    if (threadIdx.x == 0) (void)xb_add(&bar[XB_XCNT(b.x)], 1u);
    return b;
}
__device__ __forceinline__ void xcd_barrier_complete(unsigned* bar, unsigned x, unsigned& nloc, unsigned& nx) {
    const unsigned G = gridDim.x * gridDim.y * gridDim.z;
    unsigned sum, cnt, mine, sp = 0u;
    for (;;) {
        sum = 0u; cnt = 0u; mine = 0u;
#pragma unroll
        for (unsigned j = 0; j < 16; ++j) { const unsigned c = xb_ld(&bar[XB_XCNT(j)]); sum += c; cnt += (c > 0u) ? 1u : 0u; mine = (j == x) ? c : mine; }
        if (sum == G) break;
        __builtin_amdgcn_s_sleep(1);
        if ((++sp & 255u) == 0u) { if (xb_ld(&bar[XB_TMO])) break; if (sp > XB_SPIN_CAP) { atomicAdd(&bar[XB_TMO], 1u); break; } }
    }
    nloc = mine > 0u ? mine : 1u; nx = cnt > 0u ? cnt : 1u;
}
__device__ __forceinline__ void xcd_barrier(const XcdBarrier& b) {
    asm volatile("s_waitcnt vmcnt(0)" ::: "memory");
    __syncthreads();
    if (threadIdx.x == 0) {
        unsigned* bar = b.bar;
        __builtin_amdgcn_s_waitcnt(0);
        unsigned nloc = b.st[0], nx = b.st[1];
        if (nloc == 0u) { xcd_barrier_complete(bar, b.x, nloc, nx); b.st[0] = nloc; b.st[1] = nx; }
        const unsigned old = xb_add(&bar[XB_XSUB(b.x)], 1u);
        const unsigned gen = old / nloc;
        if (old + 1u == (gen + 1u) * nloc) {
            __builtin_amdgcn_fence(__ATOMIC_RELEASE, "agent");
            asm volatile("s_waitcnt vmcnt(0)" ::: "memory");
            const unsigned og = xb_add(&bar[XB_TOP], 1u);
            const unsigned tg = og / nx;
            if (og + 1u == (tg + 1u) * nx) xb_add(&bar[XB_TOPGEN], 1u);
            else XB_SPIN(xb_ld(&bar[XB_TOPGEN]) == tg, bar);
            __builtin_amdgcn_fence(__ATOMIC_ACQUIRE, "agent");
            xb_add(&bar[XB_XGEN(b.x)], 1u);
            asm volatile("s_waitcnt vmcnt(0)" ::: "memory");
        } else {
            XB_SPIN(xb_ld(&bar[XB_XGEN(b.x)]) == gen, bar);
            __builtin_amdgcn_fence(__ATOMIC_ACQUIRE, "agent");
            asm volatile("s_waitcnt vmcnt(0)" ::: "memory");
        }
    }
    __syncthreads();
}

constexpr int N_PHASES = 15;
#ifndef DUPM
#define DUPM 0
#endif
__global__ void __launch_bounds__(256, 2) mk_fwd(Params P, int ph_lo, int ph_hi, int coop) {
    __shared__ __attribute__((aligned(16))) unsigned char smem[SMEM_BYTES];
    __shared__ uint4 xb_words;
    if (threadIdx.x == 0) xb_words = make_uint4(0u, 0u, 0u, 0u);
    __syncthreads();
    XcdBarrier xb; xb.bar = (unsigned*)(P.ws + WS_BAR); xb.x = 0; xb.st = (volatile LAS unsigned*)&xb_words;
    if (coop) xb = xcd_barrier_post((unsigned*)(P.ws + WS_BAR), (volatile LAS unsigned*)&xb_words);
    if (coop > 1) cg::this_grid().sync();
    for (int ph = ph_lo; ph < ph_hi; ++ph) {
        if (coop && ph > ph_lo) xcd_barrier(xb);
        const int l = (ph == 0) ? 0 : (ph - 1) / 7, k = (ph == 0) ? 0 : ((ph - 1) % 7 + 1);
        {
            switch (k) {
                case 0: phase0(P, smem); break;
                case 1: phase1(P, l, smem); break;
                case 2: phase2(P, l, smem); break;
                case 3: phase3(P, l, smem); break;
                case 4: phase4(P, l, smem); break;
                case 5: phase5(P, l, smem); break;
                case 6: phase6(P, l, smem); break;
                default: phase7(P, l); break;
            }
        }
    }
}

extern "C" void kernel_launch(void* const* d_in, const int* in_sizes, int n_in, void* d_out, int out_size, void* d_ws, size_t ws_size, hipStream_t stream) {
    (void)in_sizes; (void)n_in; (void)out_size; (void)ws_size;
    Params P{};
    for (int i = 0; i < 26; ++i) P.in[i] = (const float*)d_in[i];
    P.out = (float*)d_out;
    P.ws = (unsigned char*)d_ws;
    static int grid_blocks = 0;
    if (!grid_blocks) {
        int dev = 0, cus = 0, per_cu = 0;
        hipGetDevice(&dev);
        hipDeviceGetAttribute(&cus, hipDeviceAttributeMultiprocessorCount, dev);
        hipOccupancyMaxActiveBlocksPerMultiprocessor(&per_cu, mk_fwd, 256, 0);
        if (per_cu > 2) per_cu = 2;
        if (per_cu < 1) per_cu = 1;
        grid_blocks = cus * per_cu;
    }
#if ML
    for (int ph = 0; ph < N_PHASES; ++ph) {
        hipLaunchKernelGGL(mk_fwd, dim3(grid_blocks), dim3(256), 0, stream, P, ph, ph + 1, 0);
    }
#else
    (void)hipMemsetAsync((unsigned char*)d_ws + WS_BAR, 0, 16384, stream);
    int lo = 0, hi = N_PHASES, coop = 1;
    void* args[] = {&P, &lo, &hi, &coop};
    hipError_t e = hipLaunchCooperativeKernel((void*)mk_fwd, dim3(grid_blocks), dim3(256), args, 0, stream);
    if (e != hipSuccess) fprintf(stderr, "cooperative launch failed: %s (grid %d)\n", hipGetErrorString(e), grid_blocks);
#endif
}
```

```cpp
#include <hip/hip_runtime.h>
#include <hip/hip_cooperative_groups.h>
#include <cstdio>
#include <cstdint>
namespace cg = cooperative_groups;

#ifndef ML
#define ML 0
#endif

typedef unsigned short u16;
typedef short bf16x8 __attribute__((ext_vector_type(8)));
typedef short bf16x4 __attribute__((ext_vector_type(4)));
typedef float f32x4 __attribute__((ext_vector_type(4)));

constexpr int DM = 1024, TP = 16384, TS = 128, TT = TP + TS, SEQL = 8192, NPROJ = 3840, NIN = 6912;
constexpr int OQ = 0, OKK = 512, OV = 640, OZA = 768, OUB = 1280, OZB = 1792, OUC = 2304, OVC = 2816, OZC = 3328, OG = 3840;
constexpr float ALPHA_C = 1.41421356237f;

constexpr size_t WS_PROJ = 0;
constexpr size_t WS_XBF  = WS_PROJ + (size_t)TT * NPROJ * 2;
constexpr size_t WS_MRG  = WS_XBF + (size_t)TT * DM * 2;
constexpr size_t WS_WIN  = WS_MRG + (size_t)TT * DM * 2;
constexpr size_t WS_WR   = WS_WIN + (size_t)2 * NIN * DM * 2;
constexpr size_t WS_WO   = WS_WR + (size_t)2 * 3 * 1024 * 512 * 2;
constexpr size_t WS_GLU  = WS_WO + (size_t)2 * 1024 * 1024 * 2;
constexpr size_t WS_SGUW = WS_GLU + (size_t)2 * 512 * 512 * 2;
constexpr size_t WS_VT   = WS_SGUW + (size_t)2 * 4 * 128 * 128 * 2;
constexpr size_t WS_ABAR = WS_VT + (size_t)2 * 2 * 64 * 8192 * 2;
constexpr size_t WS_A128 = WS_ABAR + (size_t)2 * 32 * 64 * 2 * 4;
constexpr size_t WS_BBT  = WS_A128 + (size_t)2 * 32 * 64 * 2 * 4;
constexpr size_t WS_CMT  = WS_BBT + (size_t)2 * 32 * 128 * 16 * 2;
constexpr size_t WS_SST  = WS_CMT + (size_t)2 * 32 * 16 * 128 * 2;
constexpr size_t WS_GX   = WS_SST + (size_t)128 * 32 * 128 * 4;
constexpr size_t WS_BAR  = WS_GX + (size_t)TT * 256 * 2;
constexpr size_t WS_END  = WS_BAR + 16384;

constexpr size_t O_YP = 0, O_YS = 16777216, O_KP = 16908288, O_VP = 16973824, O_HRP = 17039360, O_HIP = 17047552,
                 O_KS = 17055744, O_VS = 17088512, O_HRS = 17121280, O_HIS = 17645568, O_VC = 18169856;

struct Params {
    const float* in[26];
    float* out;
    unsigned char* ws;
};

constexpr int SMEM_BYTES = 73728;
constexpr int LDT = 72;

__device__ __forceinline__ unsigned cvt_pk_bf16(float lo, float hi) { unsigned r; asm volatile("v_cvt_pk_bf16_f32 %0, %1, %2" : "=v"(r) : "v"(lo), "v"(hi)); return r; }
__device__ __forceinline__ u16 f2bf(float f) { return (u16)(cvt_pk_bf16(f, 0.f) & 0xffffu); }
__device__ __forceinline__ float bf2f(u16 h) { return __uint_as_float(((unsigned)h) << 16); }
__device__ __forceinline__ float bflo(unsigned w) { return __uint_as_float(w << 16); }
__device__ __forceinline__ float bfhi(unsigned w) { return __uint_as_float(w & 0xffff0000u); }
__device__ __forceinline__ float sigmoidf_(float x) { return 1.0f / (1.0f + __expf(-x)); }
__device__ __forceinline__ float siluf_(float x) { return x / (1.0f + __expf(-x)); }
__device__ __forceinline__ float geluf_(float y) { const float z = 0.7978845608f * (y + 0.044715f * y * y * y); return y / (1.0f + __expf(-2.0f * z)); }
__device__ __forceinline__ f32x4 mfma32(bf16x8 a, bf16x8 b, f32x4 c) { return __builtin_amdgcn_mfma_f32_16x16x32_bf16(a, b, c, 0, 0, 0); }
__device__ __forceinline__ f32x4 mfma16(bf16x4 a, bf16x4 b, f32x4 c) { return __builtin_amdgcn_mfma_f32_16x16x16bf16_1k(a, b, c, 0, 0, 0); }
__device__ __forceinline__ void store_bf4(u16* p, float a, float b, float c, float d) { uint2 w; w.x = cvt_pk_bf16(a, b); w.y = cvt_pk_bf16(c, d); *(uint2*)p = w; }
__device__ __forceinline__ int otid() { int t = threadIdx.x; asm volatile("" : "+v"(t)); return t; }
__device__ __forceinline__ float wave_sum(float v) {
#pragma unroll
    for (int o = 32; o > 0; o >>= 1) v += __shfl_xor(v, o);
    return v;
}
__device__ __forceinline__ float wave_max(float v) {
#pragma unroll
    for (int o = 32; o > 0; o >>= 1) v = fmaxf(v, __shfl_xor(v, o));
    return v;
}

__device__ __forceinline__ size_t wt_ofs(int n, int k, int K) { return ((size_t)((n >> 8) * (K >> 5) + (k >> 5))) * 8192 + (size_t)((n & 255) * 32 + (k & 31)); }

__device__ __forceinline__ size_t xt_ofs(int tok, int k) { return ((size_t)((tok >> 7) * 32 + (k >> 5))) * 4096 + (size_t)((tok & 127) * 32 + (k & 31)); }

template <int TM, int TN, int WM, int WN, bool WT = false, bool XT = false>
__device__ __forceinline__ void gemm_accum(f32x4 (&acc)[TM][TN], const u16* __restrict__ W, const int ldw,
                                           const u16* __restrict__ X, const int ldx, const int K, u16* lds, const int wn0 = 0) {
    constexpr int WR = 16 * TM * WM, XR = 16 * TN * WN, WCH = WR * 8, XCH = XR * 8;
    constexpr int NW = (WCH + 255) / 256, NX = (XCH + 255) / 256;
    static_assert(NW <= 4 && NX <= 4, "tile too large");
    u16* As = lds;
    u16* Bs = lds + 2 * WR * LDT;
    const int tid = otid(), lane = tid & 63, wid = tid >> 6, wm = wid / WN, wn = wid % WN, fr = lane & 15, fq = lane >> 4;
    const int lrow = tid >> 3, lcol = (tid & 7) * 8;
    const u16* Wp = W + (size_t)lrow * ldw + lcol;
    const u16* Xp = X + (size_t)lrow * ldx + lcol;
    uint4 rw0, rw1, rw2, rw3, rx0, rx1, rx2, rx3;
    rw0 = rw1 = rw2 = rw3 = rx0 = rx1 = rx2 = rx3 = make_uint4(0, 0, 0, 0);
#define GW_(j, k0) if (j < NW && ((WCH % 256 == 0) || (tid + 256 * j < WCH))) rw##j = WT ? *(const uint4*)(W + wt_ofs(wn0 + lrow + 32 * j, (k0) + lcol, ldw)) : *(const uint4*)(Wp + (size_t)(32 * j) * ldw + (k0));
#define GX_(j, k0) if (j < NX && ((XCH % 256 == 0) || (tid + 256 * j < XCH))) rx##j = XT ? *(const uint4*)(X + (size_t)(((k0) + lcol) >> 5) * 4096 + (lrow + 32 * j) * 32 + (((k0) + lcol) & 31)) : *(const uint4*)(Xp + (size_t)(32 * j) * ldx + (k0));
#define SW_(j, nb) if (j < NW && ((WCH % 256 == 0) || (tid + 256 * j < WCH))) *(uint4*)(As + (nb) * WR * LDT + (lrow + 32 * j) * LDT + lcol) = rw##j;
#define SX_(j, nb) if (j < NX && ((XCH % 256 == 0) || (tid + 256 * j < XCH))) *(uint4*)(Bs + (nb) * XR * LDT + (lrow + 32 * j) * LDT + lcol) = rx##j;
    GW_(0, 0) GW_(1, 0) GW_(2, 0) GW_(3, 0) GX_(0, 0) GX_(1, 0) GX_(2, 0) GX_(3, 0)
    SW_(0, 0) SW_(1, 0) SW_(2, 0) SW_(3, 0) SX_(0, 0) SX_(1, 0) SX_(2, 0) SX_(3, 0)
    __syncthreads();
    int nk = K >> 6;
    asm volatile("" : "+s"(nk));
    for (int kt = 0; kt < nk; ++kt) {
        const bool more = (kt + 1 < nk);
        if (more) {
            const int k0 = (kt + 1) << 6;
            GW_(0, k0) GW_(1, k0) GW_(2, k0) GW_(3, k0) GX_(0, k0) GX_(1, k0) GX_(2, k0) GX_(3, k0)
        }
        const u16* a_ = As + (kt & 1) * WR * LDT + (wm * TM * 16 + fr) * LDT + fq * 8;
        const u16* b_ = Bs + (kt & 1) * XR * LDT + (wn * TN * 16 + fr) * LDT + fq * 8;
#pragma unroll
        for (int ks = 0; ks < 2; ++ks) {
            bf16x8 bfr[TN];
#pragma unroll
            for (int j = 0; j < TN; ++j) bfr[j] = *(const bf16x8*)(b_ + j * 16 * LDT + ks * 32);
#pragma unroll
            for (int i = 0; i < TM; ++i) {
                const bf16x8 af = *(const bf16x8*)(a_ + i * 16 * LDT + ks * 32);
#pragma unroll
                for (int j = 0; j < TN; ++j) acc[i][j] = mfma32(af, bfr[j], acc[i][j]);
            }
        }
        if (more) {
            const int nb = (kt + 1) & 1;
            SW_(0, nb) SW_(1, nb) SW_(2, nb) SW_(3, nb) SX_(0, nb) SX_(1, nb) SX_(2, nb) SX_(3, nb)
        }
        __syncthreads();
    }
#undef GW_
#undef GX_
#undef SW_
#undef SX_
}


template <int OFF>
__device__ __forceinline__ bf16x8 lds_rd128(unsigned addr) {
    bf16x8 v;
    asm volatile("ds_read_b128 %0, %1 offset:%2" : "=v"(v) : "v"(addr), "n"(OFF) : "memory");
    return v;
}
template <bool XT>
__device__ __forceinline__ void gemm_big(f32x4 (&acc)[8][4], const u16* __restrict__ W, const int ldw,
                                         const u16* __restrict__ X, const int ldx, const int K, unsigned char* lds) {
    const int tid = otid(), lane = tid & 63, wid = tid >> 6, wm = wid >> 1, wn = wid & 1, fr = lane & 15, fq = lane >> 4;
    constexpr int STG = 24576;
    const u16* Wp = W + tid * 8;
    const u16* Xp = XT ? (X + tid * 8) : (X + (size_t)(tid >> 2) * ldx + (tid & 3) * 8);
    const size_t xs1 = XT ? (size_t)2048 : (size_t)64 * ldx; const int xks = XT ? 128 : 1;
    unsigned char* sdst = lds + tid * 16;
    const unsigned lbase = (unsigned)(size_t)(__attribute__((address_space(3))) unsigned char*)lds;
    const unsigned a_off = lbase + (wm * 128 + fr) * 64 + fq * 16;
    const unsigned b_off = lbase + 16384 + (wn * 64 + fr) * 64 + fq * 16;
#define BIG_ISSUE(stg, k0) { unsigned char* sb_ = sdst + (stg) * STG; \
        __builtin_amdgcn_global_load_lds((const unsigned*)(Wp + (size_t)(k0) * 256), (unsigned*)(sb_), 16, 0, 0); \
        __builtin_amdgcn_global_load_lds((const unsigned*)(Wp + (size_t)(k0) * 256 + 2048), (unsigned*)(sb_ + 4096), 16, 0, 0); \
        __builtin_amdgcn_global_load_lds((const unsigned*)(Wp + (size_t)(k0) * 256 + 4096), (unsigned*)(sb_ + 8192), 16, 0, 0); \
        __builtin_amdgcn_global_load_lds((const unsigned*)(Wp + (size_t)(k0) * 256 + 6144), (unsigned*)(sb_ + 12288), 16, 0, 0); \
        __builtin_amdgcn_global_load_lds((const unsigned*)(Xp + (size_t)(k0) * xks), (unsigned*)(sb_ + 16384), 16, 0, 0); \
        __builtin_amdgcn_global_load_lds((const unsigned*)(Xp + (size_t)(k0) * xks + xs1), (unsigned*)(sb_ + 20480), 16, 0, 0); }
    int nk = K >> 5;
    asm volatile("" : "+s"(nk));
    asm volatile("s_waitcnt vmcnt(0)" ::: "memory");
    BIG_ISSUE(0, 0)
    if (nk > 1) BIG_ISSUE(1, 32)
    int stage = 0;
    for (int kt = 0; kt < nk; ++kt) {
        if (kt + 1 < nk) asm volatile("s_waitcnt vmcnt(6)" ::: "memory"); else asm volatile("s_waitcnt vmcnt(0)" ::: "memory");
        __builtin_amdgcn_s_barrier();
        asm volatile("" ::: "memory");
        if (kt + 2 < nk) { int s2 = stage + 2; if (s2 >= 3) s2 -= 3; BIG_ISSUE(s2, (kt + 2) << 5) }
        const unsigned aa = a_off + stage * STG, bb = b_off + stage * STG;
        bf16x8 b0 = lds_rd128<0>(bb), b1 = lds_rd128<1024>(bb), b2 = lds_rd128<2048>(bb), b3 = lds_rd128<3072>(bb);
        bf16x8 a0 = lds_rd128<0>(aa), a1 = lds_rd128<1024>(aa), a2 = lds_rd128<2048>(aa), a3 = lds_rd128<3072>(aa);
        bf16x8 a4 = lds_rd128<4096>(aa), a5 = lds_rd128<5120>(aa), a6 = lds_rd128<6144>(aa), a7 = lds_rd128<7168>(aa);
#define BIG_ROW(i, av) acc[i][0] = mfma32(av, b0, acc[i][0]); acc[i][1] = mfma32(av, b1, acc[i][1]); acc[i][2] = mfma32(av, b2, acc[i][2]); acc[i][3] = mfma32(av, b3, acc[i][3]);
        asm volatile("s_waitcnt lgkmcnt(7)" : "+v"(b0), "+v"(b1), "+v"(b2), "+v"(b3), "+v"(a0) :: "memory");
        BIG_ROW(0, a0)
        asm volatile("s_waitcnt lgkmcnt(6)" : "+v"(a1) :: "memory");
        BIG_ROW(1, a1)
        asm volatile("s_waitcnt lgkmcnt(5)" : "+v"(a2) :: "memory");
        BIG_ROW(2, a2)
        asm volatile("s_waitcnt lgkmcnt(4)" : "+v"(a3) :: "memory");
        BIG_ROW(3, a3)
        asm volatile("s_waitcnt lgkmcnt(3)" : "+v"(a4) :: "memory");
        BIG_ROW(4, a4)
        asm volatile("s_waitcnt lgkmcnt(2)" : "+v"(a5) :: "memory");
        BIG_ROW(5, a5)
        asm volatile("s_waitcnt lgkmcnt(1)" : "+v"(a6) :: "memory");
        BIG_ROW(6, a6)
        asm volatile("s_waitcnt lgkmcnt(0)" : "+v"(a7) :: "memory");
        BIG_ROW(7, a7)
#undef BIG_ROW
        stage = (stage == 2) ? 0 : stage + 1;
    }
#undef BIG_ISSUE
    __syncthreads();
}
template <int TM, int TN, int WM, int WN, bool XT = false>
__device__ __forceinline__ void gemm_any(f32x4 (&acc)[TM][TN], const u16* __restrict__ Wmat, const int n0, const int ldw,
                                         const u16* __restrict__ X, const int ldx, const int K, unsigned char* lds) {
    if constexpr (TM == 8) gemm_big<XT>(acc, Wmat + (size_t)n0 * ldw, ldw, X, ldx, K, lds);
    else gemm_accum<TM, TN, WM, WN, true, XT>(acc, Wmat, ldw, X, ldx, K, (u16*)lds, n0);
}

#define ACC_ZERO(a) { _Pragma("unroll") for (int i_ = 0; i_ < TM; ++i_) { _Pragma("unroll") for (int j_ = 0; j_ < TN; ++j_) a[i_][j_] = (f32x4){0.f, 0.f, 0.f, 0.f}; } }
#define TILE_IDS const int tid = otid(), lane = tid & 63, wid = tid >> 6, wm = wid / WN, wn = wid % WN, fr = lane & 15, fq = lane >> 4; (void)tid; (void)wm; (void)wn;

struct TrJob { const float* src; u16* dst; int K, N, k0, n0, tiled; };
__device__ __forceinline__ TrJob tr_job(const Params& P, int id) {
    TrJob j; int t; j.tiled = 1;
    if (id < 3456) { const int l = id / 1728; t = id % 1728; j.K = 1024; j.N = NIN; j.src = P.in[6] + (size_t)l * 1024 * NIN; j.dst = (u16*)(P.ws + WS_WIN) + (size_t)l * NIN * 1024; }
    else if (id < 4224) { const int m = (id - 3456) / 128; t = (id - 3456) % 128; j.K = 512; j.N = 1024; j.src = P.in[22] + (size_t)m * 512 * 1024; j.dst = (u16*)(P.ws + WS_WR) + (size_t)m * 1024 * 512; }
    else if (id < 4736) { const int l = (id - 4224) / 256; t = (id - 4224) % 256; j.K = 1024; j.N = 1024; j.src = P.in[23] + (size_t)l * 1024 * 1024; j.dst = (u16*)(P.ws + WS_WO) + (size_t)l * 1024 * 1024; }
    else { const int l = (id - 4736) / 64; t = (id - 4736) % 64; j.tiled = 0; j.K = 512; j.N = 512; j.src = P.in[16] + (size_t)l * 512 * 512; j.dst = (u16*)(P.ws + WS_GLU) + (size_t)l * 512 * 512; }
    const int ntn = j.N / 64; j.k0 = (t / ntn) * 64; j.n0 = (t % ntn) * 64;
    return j;
}

__device__ void phase0(const Params& P, unsigned char* smem) {
    float* tl = (float*)smem;
    u16* ws16;
    const int tid = otid();
    {
        const int n = tid & 63, kk = tid >> 6, k2 = (tid & 31) * 2, nn = tid >> 5;
        float r[16];
        int id = blockIdx.x;
        TrJob j;
        if (id < 4864) { j = tr_job(P, id);
#pragma unroll
            for (int i = 0; i < 16; ++i) r[i] = __builtin_nontemporal_load(&j.src[(size_t)(j.k0 + kk + 4 * i) * j.N + j.n0 + n]); }
        while (id < 4864) {
#pragma unroll
            for (int i = 0; i < 16; ++i) tl[(kk + 4 * i) * 65 + n] = r[i];
            __syncthreads();
            const int idn = id + gridDim.x;
            TrJob jn = j;
            if (idn < 4864) { jn = tr_job(P, idn);
#pragma unroll
                for (int i = 0; i < 16; ++i) r[i] = __builtin_nontemporal_load(&jn.src[(size_t)(jn.k0 + kk + 4 * i) * jn.N + jn.n0 + n]); }
#pragma unroll
            for (int i = 0; i < 8; ++i) { const int nr = nn + 8 * i; const size_t o = j.tiled ? wt_ofs(j.n0 + nr, j.k0 + k2, j.K) : ((size_t)(j.n0 + nr) * j.K + j.k0 + k2);
                *(unsigned*)(j.dst + o) = cvt_pk_bf16(tl[k2 * 65 + nr], tl[(k2 + 1) * 65 + nr]); }
            __syncthreads();
            j = jn; id = idn;
        }
    }
    const int gtid = blockIdx.x * 256 + tid, gsz = gridDim.x * 256;
    ws16 = (u16*)(P.ws + WS_XBF);
    for (int i0 = gtid; i0 < TT * 128; i0 += 4 * gsz) {
        float4 a[4], b[4];
#pragma unroll
        for (int u = 0; u < 4; ++u) {
            const int i = i0 + u * gsz;
            if (i < TT * 128) {
                const int r = i >> 7, c = (i & 127) * 8;
                const float* sp = (r < TP) ? (P.in[0] + (size_t)r * 1024 + c) : (P.in[1] + (size_t)(r - TP) * 1024 + c);
                { const f32x4 t0 = __builtin_nontemporal_load((const f32x4*)sp), t1 = __builtin_nontemporal_load((const f32x4*)(sp + 4));
                  a[u] = make_float4(t0[0], t0[1], t0[2], t0[3]); b[u] = make_float4(t1[0], t1[1], t1[2], t1[3]); }
            }
        }
#pragma unroll
        for (int u = 0; u < 4; ++u) {
            const int i = i0 + u * gsz;
            if (i < TT * 128) {
                const int r = i >> 7, c = (i & 127) * 8;
                uint4 w; w.x = cvt_pk_bf16(a[u].x, a[u].y); w.y = cvt_pk_bf16(a[u].z, a[u].w); w.z = cvt_pk_bf16(b[u].x, b[u].y); w.w = cvt_pk_bf16(b[u].z, b[u].w);
                *(uint4*)(ws16 + xt_ofs(r, c)) = w;
            }
        }
    }
    ws16 = (u16*)(P.ws + WS_SGUW);
    for (int i = gtid; i < 2 * 4 * 128 * 128; i += gsz) {
        const int s_ = i & 127, t = (i >> 7) & 127;
        ws16[i] = (s_ <= t) ? f2bf(P.in[20][i]) : (u16)0;
    }
    for (int t = gtid; t < 65536; t += gsz) {
        const int i = t >> 4, h = t & 15;
        const int p = i & 63, g = (i >> 6) & 31, l = i >> 11;
        const float lr = P.in[8][i], li = P.in[9][i], dt = expf(P.in[10][l * 32 + g]);
        const float br = P.in[11][t], bi = P.in[12][t];
        const float cre = P.in[13][((size_t)(l * 32 + g) * 16 + h) * 64 + p], cim = P.in[14][((size_t)(l * 32 + g) * 16 + h) * 64 + p];
        const float mag = expf(lr * dt), ang = li * dt;
        const float ar = mag * cosf(ang), ai = mag * sinf(ang);
        const float den = lr * lr + li * li;
        const float cr = ((ar - 1.0f) * lr + ai * li) / den, ci = (ai * lr - (ar - 1.0f) * li) / den;
        if (h == 0) {
            float* abar = (float*)(P.ws + WS_ABAR); abar[2 * i] = ar; abar[2 * i + 1] = ai;
            float pr = ar, pi = ai;
#pragma unroll
            for (int k = 0; k < 7; ++k) { const float nr = pr * pr - pi * pi, ni = 2.0f * pr * pi; pr = nr; pi = ni; }
            float* a128 = (float*)(P.ws + WS_A128); a128[2 * i] = pr; a128[2 * i + 1] = pi;
        }
        u16* bbt = (u16*)(P.ws + WS_BBT) + (size_t)(l * 32 + g) * 128 * 16;
        bbt[p * 16 + h] = f2bf(cr * br - ci * bi);
        bbt[(64 + p) * 16 + h] = f2bf(cr * bi + ci * br);
        u16* cmt = (u16*)(P.ws + WS_CMT) + (size_t)(l * 32 + g) * 16 * 128;
        cmt[h * 128 + p] = f2bf(cre);
        cmt[h * 128 + 64 + p] = f2bf(-cim);
    }
}

#define XCD_TILE_LOOP(q, NT) for (int S_ = (int)gridDim.x >> 3, ch_ = (int)blockIdx.x & 7, q = ch_ * S_ + ((int)blockIdx.x >> 3); ch_ * S_ < (NT); ch_ += 8, q = ch_ * S_ + ((int)blockIdx.x >> 3)) if (q < (NT))

__device__ void phase1(const Params& P, int l, unsigned char* smem) {
    constexpr int TM = 8, TN = 4, WM = 2, WN = 2;
    TILE_IDS
    u16* proj = (u16*)(P.ws + WS_PROJ);
    const u16* xbf = (const u16*)(P.ws + WS_XBF);
    const u16* win = (const u16*)(P.ws + WS_WIN) + (size_t)l * NIN * 1024;
    u16* vT = (u16*)(P.ws + WS_VT);
    XCD_TILE_LOOP(id, 129 * 15) {
        const int pnl = id / 387, q5 = id % 387, tm = q5 / 3, tn = pnl * 3 + q5 % 3;
        const int tok0 = tm * 128, col0 = tn * 256;
        f32x4 acc[TM][TN];
        ACC_ZERO(acc)
        gemm_big<true>(acc, win + (size_t)col0 * 1024, 1024, xbf + (size_t)tok0 * 1024, 1024, 1024, smem);
        const bool kvrow = (tm == 63 || tm == 127 || tm == 128);
#pragma unroll
        for (int i = 0; i < TM; ++i)
#pragma unroll
            for (int j = 0; j < TN; ++j) {
                const int tok = tok0 + (wn * TN + j) * 16 + fr, col = col0 + (wm * TM + i) * 16 + 4 * fq;
                const f32x4 a = acc[i][j];
                store_bf4(proj + (size_t)tok * NPROJ + col, a[0], a[1], a[2], a[3]);
                if (tn == 2) {
                    const bool isk = col < OV;
                    const int cc = col - (isk ? OKK : OV);
                    if (kvrow) {
                        float* o;
                        if (tm == 128) o = P.out + (isk ? O_KS : O_VS) + ((size_t)l * 128 + (tok - TP)) * 128 + cc;
                        else o = P.out + (isk ? O_KP : O_VP) + (((size_t)l * 2 + (tm == 127 ? 1 : 0)) * 128 + (tok - tok0)) * 128 + cc;
                        *(f32x4*)o = a;
                    }
                    if (!isk && tm < 128) {
                        const int kvh = cc >> 6, d = cc & 63, n = tok >> 13, pos = tok & 8191;
                        u16* vp = vT + ((size_t)((n * 2 + kvh) * 64 + d)) * 8192 + pos;
#pragma unroll
                        for (int r = 0; r < 4; ++r) vp[(size_t)r * 8192] = f2bf(a[r]);
                    }
                }
            }
    }
}

__device__ void attn_item(const Params& P, int l, int item, unsigned char* smem) {
    const int tid = otid(), lane = tid & 63, wid = tid >> 6, fr = lane & 15, fq = lane >> 4;
    const int xcd_ = item & 7, s_ = (item >> 3) & 63, n = item >> 9;
    const int blk = xcd_ * 8 + (s_ >> 3), h = s_ & 7, kvh = h >> 2;
    u16* proj = (u16*)(P.ws + WS_PROJ);
    const u16* vT = (const u16*)(P.ws + WS_VT);
    u16* Ks = (u16*)smem;
    u16* VT = Ks + 256 * 72;
    const int kpos0 = (blk - 1) * 128;
    {
        uint4 kr[8], vr[8];
#pragma unroll
        for (int k = 0; k < 8; ++k) {
            const int i = tid + 256 * k;
            const int key = i >> 3, c8 = i & 7, pos = kpos0 + key, posc = pos < 0 ? 0 : pos;
            kr[k] = *(const uint4*)(proj + (size_t)(n * SEQL + posc) * NPROJ + OKK + kvh * 64 + c8 * 8);
            const int d = i >> 5, c = i & 31, vpos = kpos0 + c * 8, vposc = vpos < 0 ? 0 : vpos;
            vr[k] = *(const uint4*)(vT + ((size_t)((n * 2 + kvh) * 64 + d)) * 8192 + vposc);
        }
#pragma unroll
        for (int k = 0; k < 8; ++k) {
            const int i = tid + 256 * k;
            const int key = i >> 3, c8 = i & 7, pos = kpos0 + key;
            *(uint4*)(Ks + key * 72 + c8 * 8) = (pos >= 0) ? kr[k] : make_uint4(0, 0, 0, 0);
            const int d = i >> 5, c = i & 31, vpos = kpos0 + c * 8;
            *(uint4*)(VT + d * 264 + c * 8) = (vpos >= 0) ? vr[k] : make_uint4(0, 0, 0, 0);
        }
    }
    const int q0 = blk * 128 + wid * 32;
    const float slope = exp2f(-(float)(h + 1)), sink = P.in[7][l * 8 + h];
    bf16x8 qfa[2][2];
    uint2 zza[2][4];
#pragma unroll
    for (int nt = 0; nt < 2; ++nt) {
        const u16* rp = proj + (size_t)(n * SEQL + q0 + nt * 16 + fr) * NPROJ;
#pragma unroll
        for (int ks = 0; ks < 2; ++ks) qfa[nt][ks] = *(const bf16x8*)(rp + OQ + h * 64 + ks * 32 + fq * 8);
#pragma unroll
        for (int dt = 0; dt < 4; ++dt) zza[nt][dt] = *(const uint2*)(rp + OZA + h * 64 + dt * 16 + 4 * fq);
    }
    __syncthreads();
#pragma unroll
    for (int nt = 0; nt < 2; ++nt) {
        u16* rowp = proj + (size_t)(n * SEQL + q0 + nt * 16 + fr) * NPROJ;
        bf16x8 qf[2];
#pragma unroll
        for (int ks = 0; ks < 2; ++ks) qf[ks] = qfa[nt][ks];
        f32x4 st[10];
#pragma unroll
        for (int kt = 0; kt < 10; ++kt) {
            st[kt] = (f32x4){0.f, 0.f, 0.f, 0.f};
#pragma unroll
            for (int ks = 0; ks < 2; ++ks) {
                const bf16x8 kf = *(const bf16x8*)(Ks + (wid * 32 + kt * 16 + fr) * 72 + ks * 32 + fq * 8);
                st[kt] = mfma32(kf, qf[ks], st[kt]);
            }
        }
        const int qi = wid * 32 + nt * 16 + fr;
        float mx = sink;
#pragma unroll
        for (int kt = 0; kt < 10; ++kt)
#pragma unroll
            for (int r = 0; r < 4; ++r) {
                const int kk = wid * 32 + kt * 16 + 4 * fq + r, dist = 128 + qi - kk;
                const bool valid = (dist >= 0) && (dist <= 128) && (blk > 0 || kk >= 128);
                const float s = valid ? (st[kt][r] * 0.125f - slope * (float)dist) : -1e30f;
                st[kt][r] = s; mx = fmaxf(mx, s);
            }
        mx = fmaxf(mx, __shfl_xor(mx, 16)); mx = fmaxf(mx, __shfl_xor(mx, 32));
        float sum = 0.f;
#pragma unroll
        for (int kt = 0; kt < 10; ++kt)
#pragma unroll
            for (int r = 0; r < 4; ++r) { const float p = __expf(st[kt][r] - mx); st[kt][r] = p; sum += p; }
        sum += __shfl_xor(sum, 16); sum += __shfl_xor(sum, 32);
        const float inv = 1.0f / (sum + __expf(sink - mx));
        f32x4 o[4];
#pragma unroll
        for (int dt = 0; dt < 4; ++dt) o[dt] = (f32x4){0.f, 0.f, 0.f, 0.f};
#pragma unroll
        for (int kt = 0; kt < 10; ++kt) {
            const unsigned w0 = cvt_pk_bf16(st[kt][0] * inv, st[kt][1] * inv), w1 = cvt_pk_bf16(st[kt][2] * inv, st[kt][3] * inv);
            const bf16x4 pf = (bf16x4){(short)(w0 & 0xffff), (short)(w0 >> 16), (short)(w1 & 0xffff), (short)(w1 >> 16)};
#pragma unroll
            for (int dt = 0; dt < 4; ++dt) {
                const bf16x4 vf = *(const bf16x4*)(VT + (dt * 16 + fr) * 264 + wid * 32 + kt * 16 + 4 * fq);
                o[dt] = mfma16(vf, pf, o[dt]);
            }
        }
        uint2 zz[4];
#pragma unroll
        for (int dt = 0; dt < 4; ++dt) zz[dt] = zza[nt][dt];
#pragma unroll
        for (int dt = 0; dt < 4; ++dt) {
            const int d = h * 64 + dt * 16 + 4 * fq;
            const uint2 z = zz[dt];
            store_bf4(rowp + OQ + d, o[dt][0] * siluf_(bflo(z.x)), o[dt][1] * siluf_(bfhi(z.x)),
                      o[dt][2] * siluf_(bflo(z.y)), o[dt][3] * siluf_(bfhi(z.y)));
        }
    }
    __syncthreads();
}

__device__ void sgu_item(const Params& P, int l, int item, unsigned char* smem) {
    const int tid = otid(), lane = tid & 63, wid = tid >> 6, fr = lane & 15, fq = lane >> 4;
    const int g = (item >> 3) & 3, c = (item & 7) * 16 + (item >> 5);
    u16* proj = (u16*)(P.ws + WS_PROJ);
    const u16* sguw = (const u16*)(P.ws + WS_SGUW);
    u16* VnT = (u16*)smem;
    float* stat = (float*)(smem + 128 * 136 * 2);
    const size_t row0 = (size_t)c * 128;
    bf16x8 wfa[4][2];
#pragma unroll
    for (int ks = 0; ks < 4; ++ks)
#pragma unroll
        for (int tt = 0; tt < 2; ++tt) wfa[ks][tt] = *(const bf16x8*)(sguw + ((size_t)((l * 4 + g) * 128 + wid * 32 + tt * 16 + fr)) * 128 + ks * 32 + fq * 8);
    {
        const int q4 = lane >> 4, r16 = lane & 15;
#pragma unroll 1
        for (int ps = 0; ps < 8; ps += 4) {
            uint4 raw[4][4];
#pragma unroll
            for (int pp = 0; pp < 4; ++pp) {
                const int s_ = wid * 32 + (ps + pp) * 4 + q4;
#pragma unroll
                for (int c = 0; c < 4; ++c) raw[pp][c] = *(const uint4*)(proj + (row0 + s_) * NPROJ + OVC + r16 * 32 + c * 8);
            }
#pragma unroll
            for (int pp = 0; pp < 4; ++pp) {
                const int s_ = wid * 32 + (ps + pp) * 4 + q4;
                float sum = 0.f, sq = 0.f;
#pragma unroll
                for (int c = 0; c < 4; ++c) {
                    const uint4 w = raw[pp][c];
                    const float v[8] = {bflo(w.x), bfhi(w.x), bflo(w.y), bfhi(w.y), bflo(w.z), bfhi(w.z), bflo(w.w), bfhi(w.w)};
#pragma unroll
                    for (int e = 0; e < 8; ++e) { sum += v[e]; sq += v[e] * v[e]; }
                }
#pragma unroll
                for (int o = 1; o < 16; o <<= 1) { sum += __shfl_xor(sum, o); sq += __shfl_xor(sq, o); }
                const float mean = sum * (1.0f / 512.0f);
                const float var = fmaxf(sq * (1.0f / 512.0f) - mean * mean, 0.f);
                if (r16 == 0) { stat[2 * s_] = mean; stat[2 * s_ + 1] = rsqrtf(var + 1e-5f); }
            }
        }
    }
    __syncthreads();
    {
        const int s = tid & 127, half = tid >> 7;
        const float mean = stat[2 * s], rstd = stat[2 * s + 1];
        const u16* src = proj + (row0 + s) * NPROJ + OVC + g * 128 + half * 64;
        const float* lng = P.in[18] + l * 512 + g * 128 + half * 64;
        const float* lnb = P.in[19] + l * 512 + g * 128 + half * 64;
#pragma unroll
        for (int c8 = 0; c8 < 8; ++c8) {
            const uint4 raw = *(const uint4*)(src + c8 * 8);
            const float v[8] = {bflo(raw.x), bfhi(raw.x), bflo(raw.y), bfhi(raw.y), bflo(raw.z), bfhi(raw.z), bflo(raw.w), bfhi(raw.w)};
            const float4 g0 = *(const float4*)(lng + c8 * 8), g1 = *(const float4*)(lng + c8 * 8 + 4), b0 = *(const float4*)(lnb + c8 * 8), b1 = *(const float4*)(lnb + c8 * 8 + 4);
            const float gg[8] = {g0.x, g0.y, g0.z, g0.w, g1.x, g1.y, g1.z, g1.w}, bb[8] = {b0.x, b0.y, b0.z, b0.w, b1.x, b1.y, b1.z, b1.w};
#pragma unroll
            for (int e = 0; e < 8; ++e) {
                const int w = c8 * 8 + e;
                VnT[(half * 64 + w) * 136 + s] = f2bf((v[e] - mean) * rstd * gg[e] + bb[e]);
            }
        }
    }
    __syncthreads();
    f32x4 acc[8][2];
#pragma unroll
    for (int wt = 0; wt < 8; ++wt) { acc[wt][0] = (f32x4){0.f, 0.f, 0.f, 0.f}; acc[wt][1] = (f32x4){0.f, 0.f, 0.f, 0.f}; }
    uint2 uu[2][8], zz[2][8];
    float biasv[2];
#pragma unroll
    for (int tt = 0; tt < 2; ++tt) {
        const int t = wid * 32 + tt * 16 + fr;
        biasv[tt] = P.in[21][(l * 4 + g) * 128 + t];
        const u16* rowp = proj + (row0 + t) * NPROJ;
#pragma unroll
        for (int wt = 0; wt < 8; ++wt) { const int w = g * 128 + wt * 16 + 4 * fq; uu[tt][wt] = *(const uint2*)(rowp + OUC + w); zz[tt][wt] = *(const uint2*)(rowp + OZC + w); }
    }
#pragma unroll
    for (int ks = 0; ks < 4; ++ks) {
        if (ks <= wid) {
#pragma unroll
            for (int wt = 0; wt < 8; ++wt) {
                const bf16x8 vf = *(const bf16x8*)(VnT + (wt * 16 + fr) * 136 + ks * 32 + fq * 8);
                acc[wt][0] = mfma32(vf, wfa[ks][0], acc[wt][0]);
                acc[wt][1] = mfma32(vf, wfa[ks][1], acc[wt][1]);
            }
        }
    }
#pragma unroll
    for (int tt = 0; tt < 2; ++tt) {
        const int t = wid * 32 + tt * 16 + fr;
        const float bias = biasv[tt];
        u16* rowp = proj + (row0 + t) * NPROJ;
#pragma unroll
        for (int wt = 0; wt < 8; ++wt) {
            const int w = g * 128 + wt * 16 + 4 * fq;
            const uint2 u = uu[tt][wt], z = zz[tt][wt];
            const f32x4 a = acc[wt][tt];
            store_bf4(rowp + OUC + w, bflo(u.x) * (a[0] + bias) * siluf_(bflo(z.x)), bfhi(u.x) * (a[1] + bias) * siluf_(bfhi(z.x)),
                      bflo(u.y) * (a[2] + bias) * siluf_(bflo(z.y)), bfhi(u.y) * (a[3] + bias) * siluf_(bfhi(z.y)));
        }
    }
    __syncthreads();
}

template <bool FULL>
__device__ void s5_item(const Params& P, int l, int item, unsigned char* smem) {
    const int tid = otid(), lane = tid & 63, wid = tid >> 6, fr = lane & 15, fq = lane >> 4;
    const int tau = item * 4 + wid, g = tau & 31, c = tau >> 5;
    float* xs = (float*)smem + wid * (16 * 132);
    u16* hs = (u16*)(smem + 4 * 16 * 132 * 4) + wid * (16 * 136);
    u16* proj = (u16*)(P.ws + WS_PROJ);
    const float* abar = (const float*)(P.ws + WS_ABAR) + (size_t)((l * 32 + g) * 64 + lane) * 2;
    const float ar = abar[0], ai = abar[1];
    const u16* bbt = (const u16*)(P.ws + WS_BBT) + (size_t)(l * 32 + g) * 128 * 16;
    bf16x4 bfrag[8];
#pragma unroll
    for (int nt = 0; nt < 8; ++nt) bfrag[nt] = *(const bf16x4*)(bbt + (nt * 16 + fr) * 16 + 4 * fq);
    bf16x8 cfrag[4];
    float dsk[4];
    if (FULL) {
        const u16* cmt = (const u16*)(P.ws + WS_CMT) + (size_t)(l * 32 + g) * 16 * 128;
#pragma unroll
        for (int ks = 0; ks < 4; ++ks) cfrag[ks] = *(const bf16x8*)(cmt + fr * 128 + ks * 32 + fq * 8);
#pragma unroll
        for (int r = 0; r < 4; ++r) dsk[r] = P.in[15][l * 512 + g * 16 + 4 * fq + r];
    }
    float* sst = (float*)(P.ws + WS_SST);
    float hr = 0.f, hi = 0.f;
    if (FULL) {
        const int cl = c & 63;
        const float* a128 = (const float*)(P.ws + WS_A128) + (size_t)((l * 32 + g) * 64 + lane) * 2;
        const float Ar = a128[0], Ai = a128[1];
        const float* S = sst + ((size_t)(c - cl) * 32 + g) * 128;
        int j = 0;
        for (; j + 32 <= cl; j += 32) {
            float sr[32], si[32];
#pragma unroll
            for (int k = 0; k < 32; ++k) { sr[k] = S[(size_t)(j + k) * 4096 + lane]; si[k] = S[(size_t)(j + k) * 4096 + 64 + lane]; }
#pragma unroll
            for (int k = 0; k < 32; ++k) { const float nr = Ar * hr - Ai * hi + sr[k]; hi = Ar * hi + Ai * hr + si[k]; hr = nr; }
        }
        for (; j + 8 <= cl; j += 8) {
            float sr[8], si[8];
#pragma unroll
            for (int k = 0; k < 8; ++k) { sr[k] = S[(size_t)(j + k) * 4096 + lane]; si[k] = S[(size_t)(j + k) * 4096 + 64 + lane]; }
#pragma unroll
            for (int k = 0; k < 8; ++k) { const float nr = Ar * hr - Ai * hi + sr[k]; hi = Ar * hi + Ai * hr + si[k]; hr = nr; }
        }
        for (; j < cl; ++j) {
            const float sr = S[(size_t)j * 4096 + lane], si = S[(size_t)j * 4096 + 64 + lane];
            const float nr = Ar * hr - Ai * hi + sr; hi = Ar * hi + Ai * hr + si; hr = nr;
        }
    }
    u16* ub = proj + (size_t)(c * 128) * NPROJ + OUB + g * 16 + 4 * fq;
    bf16x4 ufs[8];
#pragma unroll
    for (int sc = 0; sc < 8; ++sc) ufs[sc] = *(const bf16x4*)(ub + (size_t)(sc * 16 + fr) * NPROJ);
#pragma unroll
    for (int sc = 0; sc < 8; ++sc) {
        u16* up = ub + (size_t)(sc * 16 + fr) * NPROJ;
        const bf16x4 uf = ufs[sc];
#pragma unroll
        for (int nt = 0; nt < 8; ++nt) {
            const f32x4 x = mfma16(uf, bfrag[nt], (f32x4){0.f, 0.f, 0.f, 0.f});
#pragma unroll
            for (int r = 0; r < 4; ++r) xs[(4 * fq + r) * 132 + nt * 16 + fr] = x[r];
        }
        __syncthreads();
        float xrv[16], xiv[16];
#pragma unroll
        for (int t = 0; t < 16; ++t) { xrv[t] = xs[t * 132 + lane]; xiv[t] = xs[t * 132 + 64 + lane]; }
#pragma unroll
        for (int t = 0; t < 16; ++t) {
            const float xr = xrv[t], xi = xiv[t];
            const float nr = ar * hr - ai * hi + xr; hi = ar * hi + ai * hr + xi; hr = nr;
            if (FULL) { hs[t * 136 + lane] = f2bf(hr); hs[t * 136 + 64 + lane] = f2bf(hi); }
        }
        __syncthreads();
        if (FULL) {
            f32x4 y = (f32x4){0.f, 0.f, 0.f, 0.f};
#pragma unroll
            for (int ks = 0; ks < 4; ++ks) {
                const bf16x8 hf = *(const bf16x8*)(hs + fr * 136 + ks * 32 + fq * 8);
                y = mfma32(cfrag[ks], hf, y);
            }
            float o[4];
#pragma unroll
            for (int r = 0; r < 4; ++r) o[r] = geluf_(y[r] + dsk[r] * bf2f((u16)uf[r]));
            store_bf4(up, o[0], o[1], o[2], o[3]);
        }
    }
    if (!FULL) { float* S = sst + ((size_t)c * 32 + g) * 128; S[lane] = hr; S[64 + lane] = hi; }
    else if ((c & 63) == 63) {
        const size_t o = ((size_t)(l * 2 + (c >> 6)) * 32 + g) * 64 + lane;
        P.out[O_HRP + o] = hr; P.out[O_HIP + o] = hi;
    }
    __syncthreads();
}

__device__ void sample_item(const Params& P, int l, int b, int part, unsigned char* smem) {
    const int tid = otid(), lane = tid & 63, wid = tid >> 6;
    u16* prow = (u16*)(P.ws + WS_PROJ) + (size_t)(TP + b) * NPROJ;
    float* row = (float*)smem;
    float* sc = row + 3840;
    float* red = sc + 8 * 132;
    float* hst = red + 64;
    if (part == 0) {
        if (tid < 160) {
            const uint4 raw = *(const uint4*)(prow + tid * 8);
            float* r = row + tid * 8;
            r[0] = bflo(raw.x); r[1] = bfhi(raw.x); r[2] = bflo(raw.y); r[3] = bfhi(raw.y); r[4] = bflo(raw.z); r[5] = bfhi(raw.z); r[6] = bflo(raw.w); r[7] = bfhi(raw.w);
        }
        __syncthreads();
        {
            const int j = tid & 127, kvh = tid >> 7;
            const float* ck = P.in[2] + (((size_t)l * 128 + b) * 128 + j) * 128 + kvh * 64;
            float4 kk[16];
#pragma unroll
            for (int d = 0; d < 16; ++d) { const f32x4 t_ = __builtin_nontemporal_load((const f32x4*)(ck + 4 * d)); kk[d] = make_float4(t_[0], t_[1], t_[2], t_[3]); }
            const float* q = row + OQ + kvh * 256;
            float d0 = 0.f, d1 = 0.f, d2 = 0.f, d3 = 0.f;
#pragma unroll
            for (int d4 = 0; d4 < 16; ++d4) {
                const int d = 4 * d4; const float4 k4 = kk[d4];
                d0 += q[d] * k4.x + q[d + 1] * k4.y + q[d + 2] * k4.z + q[d + 3] * k4.w;
                d1 += q[64 + d] * k4.x + q[64 + d + 1] * k4.y + q[64 + d + 2] * k4.z + q[64 + d + 3] * k4.w;
                d2 += q[128 + d] * k4.x + q[128 + d + 1] * k4.y + q[128 + d + 2] * k4.z + q[128 + d + 3] * k4.w;
                d3 += q[192 + d] * k4.x + q[192 + d + 1] * k4.y + q[192 + d + 2] * k4.z + q[192 + d + 3] * k4.w;
            }
            const float dist = (float)(128 - j);
            const int h0 = kvh * 4;
            sc[(h0 + 0) * 132 + j] = d0 * 0.125f - exp2f(-(float)(h0 + 1)) * dist;
            sc[(h0 + 1) * 132 + j] = d1 * 0.125f - exp2f(-(float)(h0 + 2)) * dist;
            sc[(h0 + 2) * 132 + j] = d2 * 0.125f - exp2f(-(float)(h0 + 3)) * dist;
            sc[(h0 + 3) * 132 + j] = d3 * 0.125f - exp2f(-(float)(h0 + 4)) * dist;
            if (tid < 8) {
                const int h = tid;
                const float* qq = row + OQ + h * 64; const float* k2 = row + OKK + (h >> 2) * 64;
                float d = 0.f;
                for (int e = 0; e < 64; ++e) d += qq[e] * k2[e];
                sc[h * 132 + 128] = d * 0.125f;
            }
        }
        __syncthreads();
#pragma unroll
        for (int hh = 0; hh < 2; ++hh) {
            const int h = wid * 2 + hh;
            const float sink = P.in[7][l * 8 + h];
            const float s0 = sc[h * 132 + lane], s1 = sc[h * 132 + 64 + lane], s2 = (lane == 0) ? sc[h * 132 + 128] : -1e30f;
            const float mx = fmaxf(wave_max(fmaxf(fmaxf(s0, s1), s2)), sink);
            const float e0 = __expf(s0 - mx), e1 = __expf(s1 - mx), e2 = (lane == 0) ? __expf(s2 - mx) : 0.f;
            const float inv = 1.0f / (wave_sum(e0 + e1 + e2) + __expf(sink - mx));
            sc[h * 132 + lane] = e0 * inv; sc[h * 132 + 64 + lane] = e1 * inv;
            if (lane == 0) sc[h * 132 + 128] = e2 * inv;
        }
        __syncthreads();
        {
            const int d = tid & 63, jq = (tid >> 6) & 1, kvh = tid >> 7;
            const float* cv = P.in[3] + (((size_t)l * 128 + b) * 128 + jq * 64) * 128 + kvh * 64 + d;
            const float* p = sc + (kvh * 4) * 132 + jq * 64;
            float a0 = 0.f, a1 = 0.f, a2 = 0.f, a3 = 0.f;
#pragma unroll
            for (int jb = 0; jb < 64; jb += 32) {
                float vv[32];
#pragma unroll
                for (int j = 0; j < 32; ++j) vv[j] = __builtin_nontemporal_load(&cv[(size_t)(jb + j) * 128]);
#pragma unroll
                for (int j = 0; j < 32; ++j) { a0 += p[jb + j] * vv[j]; a1 += p[132 + jb + j] * vv[j]; a2 += p[264 + jb + j] * vv[j]; a3 += p[396 + jb + j] * vv[j]; }
            }
            float* pp = hst + ((kvh * 2 + jq) * 4) * 64 + d;
            pp[0] = a0; pp[64] = a1; pp[128] = a2; pp[192] = a3;
        }
        __syncthreads();
#pragma unroll
        for (int rep = 0; rep < 2; ++rep) {
            const int idx = tid + rep * 256, h = idx >> 6, d = idx & 63, kvh = h >> 2, hh = h & 3;
            const float acc = hst[((kvh * 2 + 0) * 4 + hh) * 64 + d] + hst[((kvh * 2 + 1) * 4 + hh) * 64 + d] + sc[h * 132 + 128] * row[OV + kvh * 64 + d];
            prow[OQ + idx] = f2bf(acc * siluf_(row[OZA + idx]));
        }
    } else {
        {
            const int c = (tid < 64) ? (OUB + tid * 8) : (OUC + (tid - 64) * 8);
            const uint4 raw = *(const uint4*)(prow + c);
            float* r = row + c;
            r[0] = bflo(raw.x); r[1] = bfhi(raw.x); r[2] = bflo(raw.y); r[3] = bfhi(raw.y); r[4] = bflo(raw.z); r[5] = bfhi(raw.z); r[6] = bflo(raw.w); r[7] = bfhi(raw.w);
        }
        __syncthreads();
        {
            const int p = lane;
            const float* abar = (const float*)(P.ws + WS_ABAR);
#pragma unroll
            for (int gi = 0; gi < 8; ++gi) {
                const int g = wid + 4 * gi;
                const u16* bb = (const u16*)(P.ws + WS_BBT) + (size_t)(l * 32 + g) * 128 * 16;
                const uint4 r0 = *(const uint4*)(bb + p * 16), r1 = *(const uint4*)(bb + p * 16 + 8);
                const uint4 i0 = *(const uint4*)(bb + (64 + p) * 16), i1 = *(const uint4*)(bb + (64 + p) * 16 + 8);
                const float* u = row + OUB + g * 16;
                const float xr = bflo(r0.x) * u[0] + bfhi(r0.x) * u[1] + bflo(r0.y) * u[2] + bfhi(r0.y) * u[3] + bflo(r0.z) * u[4] + bfhi(r0.z) * u[5] + bflo(r0.w) * u[6] + bfhi(r0.w) * u[7]
                               + bflo(r1.x) * u[8] + bfhi(r1.x) * u[9] + bflo(r1.y) * u[10] + bfhi(r1.y) * u[11] + bflo(r1.z) * u[12] + bfhi(r1.z) * u[13] + bflo(r1.w) * u[14] + bfhi(r1.w) * u[15];
                const float xi = bflo(i0.x) * u[0] + bfhi(i0.x) * u[1] + bflo(i0.y) * u[2] + bfhi(i0.y) * u[3] + bflo(i0.z) * u[4] + bfhi(i0.z) * u[5] + bflo(i0.w) * u[6] + bfhi(i0.w) * u[7]
                               + bflo(i1.x) * u[8] + bfhi(i1.x) * u[9] + bflo(i1.y) * u[10] + bfhi(i1.y) * u[11] + bflo(i1.z) * u[12] + bfhi(i1.z) * u[13] + bflo(i1.w) * u[14] + bfhi(i1.w) * u[15];
                const size_t si = (((size_t)l * 128 + b) * 32 + g) * 64 + p;
                const float h0r = P.in[4][si], h0i = P.in[5][si];
                const float ar = abar[((l * 32 + g) * 64 + p) * 2], ai = abar[((l * 32 + g) * 64 + p) * 2 + 1];
                const float hr = ar * h0r - ai * h0i + xr, hi = ar * h0i + ai * h0r + xi;
                P.out[O_HRS + si] = hr; P.out[O_HIS + si] = hi;
                hst[g * 128 + p] = hr; hst[g * 128 + 64 + p] = hi;
            }
        }
        __syncthreads();
#pragma unroll
        for (int rep = 0; rep < 2; ++rep) {
            const int ch = tid + rep * 256, g = ch >> 4, ho = ch & 15;
            const float* cre = P.in[13] + ((size_t)(l * 32 + g) * 16 + ho) * 64;
            const float* cim = P.in[14] + ((size_t)(l * 32 + g) * 16 + ho) * 64;
            float4 cr[16], ci[16];
#pragma unroll
            for (int k = 0; k < 16; ++k) { cr[k] = *(const float4*)(cre + 4 * k); ci[k] = *(const float4*)(cim + 4 * k); }
            const float* hh = hst + g * 128;
            float acc = 0.f;
#pragma unroll
            for (int k = 0; k < 16; ++k) {
                const int p = 4 * k;
                acc += hh[p] * cr[k].x - hh[64 + p] * ci[k].x + hh[p + 1] * cr[k].y - hh[64 + p + 1] * ci[k].y
                     + hh[p + 2] * cr[k].z - hh[64 + p + 2] * ci[k].z + hh[p + 3] * cr[k].w - hh[64 + p + 3] * ci[k].w;
            }
            const float y = acc + P.in[15][l * 512 + ch] * row[OUB + ch];
            prow[OUB + ch] = f2bf(geluf_(y));
        }
        {
            const float v0 = row[OVC + tid], v1 = row[OVC + 256 + tid];
            float s_ = wave_sum(v0 + v1);
            if (lane == 0) red[wid] = s_;
            __syncthreads();
            const float mean = (red[0] + red[1] + red[2] + red[3]) * (1.0f / 512.0f);
            const float e0 = v0 - mean, e1 = v1 - mean;
            float q = wave_sum(e0 * e0 + e1 * e1);
            if (lane == 0) red[8 + wid] = q;
            __syncthreads();
            const float rstd = rsqrtf((red[8] + red[9] + red[10] + red[11]) * (1.0f / 512.0f) + 1e-5f);
#pragma unroll
            for (int rep = 0; rep < 2; ++rep) {
                const int ch = tid + rep * 256, g = ch >> 7;
                const float vn = (rep ? e1 : e0) * rstd * P.in[18][l * 512 + ch] + P.in[19][l * 512 + ch];
                P.out[O_VC + ((size_t)l * 128 + b) * 512 + ch] = vn;
                const float sg = P.in[20][(size_t)(l * 4 + g) * 128 * 128] * vn + P.in[21][(l * 4 + g) * 128];
                prow[OUC + ch] = f2bf(row[OUC + ch] * sg * siluf_(row[OZC + ch]));
            }
        }
    }
    __syncthreads();
}

__device__ __forceinline__ u16* gate_ptr(const Params& P, int b, int tok, int c) {
    if (b == 0) return (u16*)(P.ws + WS_MRG) + (size_t)tok * 1024 + c;
    if (b == 1) return (c < 768) ? ((u16*)(P.ws + WS_PROJ) + (size_t)tok * NPROJ + 512 + c) : ((u16*)(P.ws + WS_GX) + (size_t)tok * 256 + (c - 768));
    return (u16*)(P.ws + WS_PROJ) + (size_t)tok * NPROJ + 2816 + c;
}
template <int TM, int TN, int WM, int WN>
__device__ __forceinline__ void gate_tile(const Params& P, int l, int tok0, int gcol0, unsigned char* smem) {
    TILE_IDS
    const u16* xbf = (const u16*)(P.ws + WS_XBF);
    const u16* win = (const u16*)(P.ws + WS_WIN) + (size_t)l * NIN * 1024;
    f32x4 acc[TM][TN];
    ACC_ZERO(acc)
    gemm_any<TM, TN, WM, WN, true>(acc, win, OG + gcol0, 1024, xbf + (size_t)tok0 * 1024, 1024, 1024, smem);
    const int b = gcol0 >> 10;
#pragma unroll
    for (int i = 0; i < TM; ++i)
#pragma unroll
        for (int j = 0; j < TN; ++j) {
            const int tok = tok0 + (wn * TN + j) * 16 + fr, c = (gcol0 & 1023) + (wm * TM + i) * 16 + 4 * fq;
            const f32x4 a = acc[i][j];
            store_bf4(gate_ptr(P, b, tok, c), sigmoidf_(a[0]), sigmoidf_(a[1]), sigmoidf_(a[2]), sigmoidf_(a[3]));
        }
}
__device__ void phase2(const Params& P, int l, unsigned char* smem) {
    const bool gemm_first = blockIdx.x < (gridDim.x >> 1);
#pragma unroll 1
    for (int pass = 0; pass < 2; ++pass) {
        if ((pass == 0) == gemm_first) {
            XCD_TILE_LOOP(q, 512) gate_tile<8, 4, 2, 2>(P, l, (q >> 2) * 128, (q & 3) * 256, smem);
        } else {
            if (gridDim.x == 512) {
                const int b = blockIdx.x;
                attn_item(P, l, b, smem);
                attn_item(P, l, b + 512, smem);
                sgu_item(P, l, b, smem);
                if (b < 256) {
                    sample_item(P, l, b & 127, b >> 7, smem);
                    s5_item<false>(P, l, 768 + b, smem);
                } else {
                    s5_item<false>(P, l, b - 256, smem);
                    s5_item<false>(P, l, b, smem);
                    s5_item<false>(P, l, b + 256, smem);
                }
            } else {
                for (int it = blockIdx.x; it < 2816; it += gridDim.x) {
                    if (it < 1024) attn_item(P, l, it, smem);
                    else if (it < 1536) sgu_item(P, l, it - 1024, smem);
                    else if (it < 1792) sample_item(P, l, (it - 1536) & 127, (it - 1536) >> 7, smem);
                    else s5_item<false>(P, l, it - 1792, smem);
                }
            }
        }
    }
}
__device__ void phase3(const Params& P, int l, unsigned char* smem) {
    XCD_TILE_LOOP(q, 1024) gate_tile<8, 4, 2, 2>(P, l, ((q & 511) >> 2) * 128, 1024 + (q >> 9) * 1024 + (q & 3) * 256, smem);
    for (int it = blockIdx.x; it < 1024 + 192; it += gridDim.x) {
        if (it < 1024) s5_item<true>(P, l, it, smem);
        else gate_tile<1, 2, 1, 4>(P, l, TP, (it - 1024) * 16, smem);
    }
}

template <int TM, int TN, int WM, int WN>
__device__ __forceinline__ void glu_tile(const Params& P, int l, int tok0, int col0, unsigned char* smem) {
    TILE_IDS
    u16* proj = (u16*)(P.ws + WS_PROJ);
    const u16* gw = (const u16*)(P.ws + WS_GLU) + (size_t)l * 512 * 512;
    f32x4 acc[TM][TN];
    ACC_ZERO(acc)
    gemm_accum<TM, TN, WM, WN>(acc, gw + (size_t)col0 * 512, 512, proj + (size_t)tok0 * NPROJ + OUB, NPROJ, 512, (u16*)smem);
    uint2 yy[TM][TN], zz[TM][TN];
    f32x4 gbv[TM];
#pragma unroll
    for (int i = 0; i < TM; ++i) {
        gbv[i] = *(const f32x4*)(P.in[17] + l * 512 + col0 + (wm * TM + i) * 16 + 4 * fq);
#pragma unroll
        for (int j = 0; j < TN; ++j) {
            const int tok = tok0 + (wn * TN + j) * 16 + fr, col = col0 + (wm * TM + i) * 16 + 4 * fq;
            const u16* rowp = proj + (size_t)tok * NPROJ;
            yy[i][j] = *(const uint2*)(rowp + OUB + col); zz[i][j] = *(const uint2*)(rowp + OZB + col);
        }
    }
#pragma unroll
    for (int i = 0; i < TM; ++i)
#pragma unroll
        for (int j = 0; j < TN; ++j) {
            const int tok = tok0 + (wn * TN + j) * 16 + fr, col = col0 + (wm * TM + i) * 16 + 4 * fq;
            const f32x4 gb = gbv[i];
            u16* rowp = proj + (size_t)tok * NPROJ;
            const uint2 y = yy[i][j], z = zz[i][j];
            const f32x4 a = acc[i][j];
            store_bf4(rowp + OZB + col, bflo(y.x) * sigmoidf_(a[0] + gb[0]) * siluf_(bflo(z.x)), bfhi(y.x) * sigmoidf_(a[1] + gb[1]) * siluf_(bfhi(z.x)),
                      bflo(y.y) * sigmoidf_(a[2] + gb[2]) * siluf_(bflo(z.y)), bfhi(y.y) * sigmoidf_(a[3] + gb[3]) * siluf_(bfhi(z.y)));
        }
}
__device__ void phase4(const Params& P, int l, unsigned char* smem) {
    for (int it = blockIdx.x; it < 32; it += gridDim.x) glu_tile<1, 2, 1, 4>(P, l, TP, it * 16, smem);
    XCD_TILE_LOOP(id, 512) glu_tile<4, 4, 2, 2>(P, l, (id >> 2) * 128, (id & 3) * 128, smem);
}

template <int TM, int TN, int WM, int WN>
__device__ __forceinline__ void merge_tile(const Params& P, int l, int tok0, int col0, unsigned char* smem) {
    TILE_IDS
    const u16* proj = (const u16*)(P.ws + WS_PROJ);
    const u16* wr = (const u16*)(P.ws + WS_WR) + (size_t)l * 3 * 1024 * 512;
    u16* mrg = (u16*)(P.ws + WS_MRG);
#pragma unroll 1
    for (int b = 0; b < 3; ++b) {
        f32x4 acc[TM][TN];
        ACC_ZERO(acc)
        const int yoff = (b == 0) ? OQ : ((b == 1) ? OZB : OUC);
        gemm_any<TM, TN, WM, WN>(acc, wr + (size_t)b * 1024 * 512, col0, 512, proj + (size_t)tok0 * NPROJ + yoff, NPROJ, 512, smem);
        const u16* gbase; int gstride;
        if (b == 0) { gbase = mrg + col0; gstride = 1024; }
        else if (b == 1) { if (col0 < 768) { gbase = proj + 512 + col0; gstride = NPROJ; } else { gbase = (const u16*)(P.ws + WS_GX) + (col0 - 768); gstride = 256; } }
        else { gbase = proj + 2816 + col0; gstride = NPROJ; }
        constexpr int IB = (TM >= 2) ? 2 : 1;
#pragma unroll
        for (int i0 = 0; i0 < TM; i0 += IB) {
            uint2 g[IB][TN], m[IB][TN];
#pragma unroll
            for (int ii = 0; ii < IB; ++ii)
#pragma unroll
                for (int j = 0; j < TN; ++j) {
                    const int tok = tok0 + (wn * TN + j) * 16 + fr, lc = (wm * TM + i0 + ii) * 16 + 4 * fq;
                    g[ii][j] = *(const uint2*)(gbase + (size_t)tok * gstride + lc);
                    m[ii][j] = make_uint2(0u, 0u);
                    if (b > 0) m[ii][j] = *(const uint2*)(mrg + (size_t)tok * 1024 + col0 + lc);
                }
#pragma unroll
            for (int ii = 0; ii < IB; ++ii)
#pragma unroll
                for (int j = 0; j < TN; ++j) {
                    const int tok = tok0 + (wn * TN + j) * 16 + fr, lc = (wm * TM + i0 + ii) * 16 + 4 * fq;
                    const f32x4 a = acc[i0 + ii][j];
                    store_bf4(mrg + (size_t)tok * 1024 + col0 + lc, bflo(m[ii][j].x) + bflo(g[ii][j].x) * a[0], bfhi(m[ii][j].x) + bfhi(g[ii][j].x) * a[1],
                              bflo(m[ii][j].y) + bflo(g[ii][j].y) * a[2], bfhi(m[ii][j].y) + bfhi(g[ii][j].y) * a[3]);
                }
            asm volatile("" ::: "memory");
        }
    }
}
__device__ void phase5(const Params& P, int l, unsigned char* smem) {
    for (int it = blockIdx.x; it < 64; it += gridDim.x) merge_tile<1, 2, 1, 4>(P, l, TP, it * 16, smem);
    XCD_TILE_LOOP(id, 512) merge_tile<8, 4, 2, 2>(P, l, (id >> 2) * 128, (id & 3) * 256, smem);
}

template <int TM, int TN, int WM, int WN>
__device__ __forceinline__ void oproj_tile(const Params& P, int l, int tok0, int col0, unsigned char* smem) {
    TILE_IDS
    const u16* mrg = (const u16*)(P.ws + WS_MRG);
    const u16* wo = (const u16*)(P.ws + WS_WO) + (size_t)l * 1024 * 1024;
    f32x4 acc[TM][TN];
    ACC_ZERO(acc)
    gemm_any<TM, TN, WM, WN>(acc, wo, col0, 1024, mrg + (size_t)tok0 * 1024, 1024, 1024, smem);
    constexpr int IB = (TM >= 2) ? 2 : 1;
#pragma unroll
    for (int i0 = 0; i0 < TM; i0 += IB) {
        f32x4 xr[IB][TN];
#pragma unroll
        for (int ii = 0; ii < IB; ++ii)
#pragma unroll
            for (int j = 0; j < TN; ++j) {
                const int tok = tok0 + (wn * TN + j) * 16 + fr, col = col0 + (wm * TM + i0 + ii) * 16 + 4 * fq;
                const float* res = (l == 0) ? ((tok < TP) ? (P.in[0] + (size_t)tok * 1024 + col) : (P.in[1] + (size_t)(tok - TP) * 1024 + col))
                                            : (P.out + (size_t)tok * 1024 + col);
                xr[ii][j] = __builtin_nontemporal_load((const f32x4*)res);
            }
#pragma unroll
        for (int ii = 0; ii < IB; ++ii)
#pragma unroll
            for (int j = 0; j < TN; ++j) {
                const int tok = tok0 + (wn * TN + j) * 16 + fr, col = col0 + (wm * TM + i0 + ii) * 16 + 4 * fq;
                *(f32x4*)(P.out + (size_t)tok * 1024 + col) = xr[ii][j] * ALPHA_C + acc[i0 + ii][j];
            }
        asm volatile("" ::: "memory");
    }
}
__device__ void phase6(const Params& P, int l, unsigned char* smem) {
    for (int it = blockIdx.x; it < 64; it += gridDim.x) oproj_tile<1, 2, 1, 4>(P, l, TP, it * 16, smem);
    XCD_TILE_LOOP(id, 512) oproj_tile<8, 4, 2, 2>(P, l, (id >> 2) * 128, (id & 3) * 256, smem);
}

__device__ void phase7(const Params& P, int l) {
    const int tid = otid(), lane = tid & 63;
    const int gw = blockIdx.x * 4 + (tid >> 6), nw = gridDim.x * 4;
    u16* xbf = (u16*)(P.ws + WS_XBF);
    const float* g = P.in[24] + l * 1024; const float* bta = P.in[25] + l * 1024;
    for (int row0 = gw; row0 < TT; row0 += 2 * nw) {
        const int row1 = row0 + nw;
        const bool has1 = row1 < TT;
        float* xr0 = P.out + (size_t)row0 * 1024;
        float* xr1 = P.out + (size_t)(has1 ? row1 : row0) * 1024;
        f32x4 v0[4], v1[4];
#pragma unroll
        for (int i = 0; i < 4; ++i) { v0[i] = __builtin_nontemporal_load((const f32x4*)(xr0 + i * 256 + lane * 4)); v1[i] = __builtin_nontemporal_load((const f32x4*)(xr1 + i * 256 + lane * 4)); }
        float s0 = 0.f, s1 = 0.f;
#pragma unroll
        for (int i = 0; i < 4; ++i) { s0 += (v0[i][0] + v0[i][1]) + (v0[i][2] + v0[i][3]); s1 += (v1[i][0] + v1[i][1]) + (v1[i][2] + v1[i][3]); }
        const float m0 = wave_sum(s0) * (1.0f / 1024.0f), m1 = wave_sum(s1) * (1.0f / 1024.0f);
        float q0 = 0.f, q1 = 0.f;
#pragma unroll
        for (int i = 0; i < 4; ++i) {
            v0[i] = v0[i] - m0; q0 += (v0[i][0] * v0[i][0] + v0[i][1] * v0[i][1]) + (v0[i][2] * v0[i][2] + v0[i][3] * v0[i][3]);
            v1[i] = v1[i] - m1; q1 += (v1[i][0] * v1[i][0] + v1[i][1] * v1[i][1]) + (v1[i][2] * v1[i][2] + v1[i][3] * v1[i][3]);
        }
        const float r0 = rsqrtf(wave_sum(q0) * (1.0f / 1024.0f) + 1e-5f), r1 = rsqrtf(wave_sum(q1) * (1.0f / 1024.0f) + 1e-5f);
#pragma unroll
        for (int i = 0; i < 4; ++i) {
            const int c = i * 256 + lane * 4;
            const f32x4 gg = *(const f32x4*)(g + c), bb = *(const f32x4*)(bta + c);
            const f32x4 y0 = v0[i] * r0 * gg + bb, y1 = v1[i] * r1 * gg + bb;
            __builtin_nontemporal_store(y0, (f32x4*)(xr0 + c));
            if (l == 0) store_bf4(xbf + xt_ofs(row0, c), y0[0], y0[1], y0[2], y0[3]);
            if (has1) {
                __builtin_nontemporal_store(y1, (f32x4*)(xr1 + c));
                if (l == 0) store_bf4(xbf + xt_ofs(row1, c), y1[0], y1[1], y1[2], y1[3]);
            }
        }
    }
}

#define XB_TMO      128
#define XB_XCNT(j)  (256  + 64 * (j))
#define XB_XSUB(j)  (1280 + 64 * (j))
#define XB_XGEN(j)  (2304 + 64 * (j))
#define XB_TOP      3328
#define XB_TOPGEN   3392
#define XCD_BAR_WORDS 3456
#define XB_SPIN_CAP (1u << 18)
#define LAS __attribute__((address_space(3)))
__device__ __forceinline__ unsigned xb_ld(unsigned* p)              { return __hip_atomic_load(p, __ATOMIC_RELAXED, __HIP_MEMORY_SCOPE_AGENT); }
__device__ __forceinline__ unsigned xb_add(unsigned* p, unsigned v) { return __hip_atomic_fetch_add(p, v, __ATOMIC_RELAXED, __HIP_MEMORY_SCOPE_AGENT); }
__device__ __forceinline__ unsigned xb_xcc_id() { return (unsigned)__builtin_amdgcn_s_getreg((3 << 11) | 20) & 0xFu; }
#define XB_SPIN(cond, bar) do { unsigned _sp = 0; while (cond) { __builtin_amdgcn_s_sleep(1); \
    if ((++_sp & 255u) == 0u) { if (xb_ld(&(bar)[XB_TMO])) break; if (_sp > XB_SPIN_CAP) { atomicAdd(&(bar)[XB_TMO], 1u); break; } } } } while (0)
struct XcdBarrier { unsigned* bar; unsigned x; volatile LAS unsigned* st; };
__device__ __forceinline__ XcdBarrier xcd_barrier_post(unsigned* bar, volatile LAS unsigned* st) {
    XcdBarrier b; b.bar = bar; b.x = xb_xcc_id(); b.st = st;
    if (threadIdx.x == 0) (void)xb_add(&bar[XB_XCNT(b.x)], 1u);
    return b;
}
__device__ __forceinline__ void xcd_barrier_complete(unsigned* bar, unsigned x, unsigned& nloc, unsigned& nx) {
    const unsigned G = gridDim.x * gridDim.y * gridDim.z;
    unsigned sum, cnt, mine, sp = 0u;
    for (;;) {
        sum = 0u; cnt = 0u; mine = 0u;
#pragma unroll
        for (unsigned j = 0; j < 16; ++j) { const unsigned c = xb_ld(&bar[XB_XCNT(j)]); sum += c; cnt += (c > 0u) ? 1u : 0u; mine = (j == x) ? c : mine; }
        if (sum == G) break;
        __builtin_amdgcn_s_sleep(1);
        if ((++sp & 255u) == 0u) { if (xb_ld(&bar[XB_TMO])) break; if (sp > XB_SPIN_CAP) { atomicAdd(&bar[XB_TMO], 1u); break; } }
    }
    nloc = mine > 0u ? mine : 1u; nx = cnt > 0u ? cnt : 1u;
}
__device__ __forceinline__ void xcd_barrier(const XcdBarrier& b) {
    asm volatile("s_waitcnt vmcnt(0)" ::: "memory");
    __syncthreads();
    if (threadIdx.x == 0) {
        unsigned* bar = b.bar;
        __builtin_amdgcn_s_waitcnt(0);
        unsigned nloc = b.st[0], nx = b.st[1];
        if (nloc == 0u) { xcd_barrier_complete(bar, b.x, nloc, nx); b.st[0] = nloc; b.st[1] = nx; }
        const unsigned old = xb_add(&bar[XB_XSUB(b.x)], 1u);
        const unsigned gen = old / nloc;
        if (old + 1u == (gen + 1u) * nloc) {
            __builtin_amdgcn_fence(__ATOMIC_RELEASE, "agent");
            asm volatile("s_waitcnt vmcnt(0)" ::: "memory");
            const unsigned og = xb_add(&bar[XB_TOP], 1u);
            const unsigned tg = og / nx;
            if (og + 1u == (tg + 1u) * nx) xb_add(&bar[XB_TOPGEN], 1u);
            else XB_SPIN(xb_ld(&bar[XB_TOPGEN]) == tg, bar);
            __builtin_amdgcn_fence(__ATOMIC_ACQUIRE, "agent");
            xb_add(&bar[XB_XGEN(b.x)], 1u);
            asm volatile("s_waitcnt vmcnt(0)" ::: "memory");
        } else {
            XB_SPIN(xb_ld(&bar[XB_XGEN(b.x)]) == gen, bar);
            __builtin_amdgcn_fence(__ATOMIC_ACQUIRE, "agent");
            asm volatile("s_waitcnt vmcnt(0)" ::: "memory");
        }
    }
    __syncthreads();
}

constexpr int N_PHASES = 15;
#ifndef DUPM
#define DUPM 0
#endif
__global__ void __launch_bounds__(256, 2) mk_fwd(Params P, int ph_lo, int ph_hi, int coop) {
    __shared__ __attribute__((aligned(16))) unsigned char smem[SMEM_BYTES];
    __shared__ uint4 xb_words;
    if (threadIdx.x == 0) xb_words = make_uint4(0u, 0u, 0u, 0u);
    __syncthreads();
    XcdBarrier xb; xb.bar = (unsigned*)(P.ws + WS_BAR); xb.x = 0; xb.st = (volatile LAS unsigned*)&xb_words;
    if (coop) xb = xcd_barrier_post((unsigned*)(P.ws + WS_BAR), (volatile LAS unsigned*)&xb_words);
    if (coop > 1) cg::this_grid().sync();
    for (int ph = ph_lo; ph < ph_hi; ++ph) {
        if (coop && ph > ph_lo) xcd_barrier(xb);
        const int l = (ph == 0) ? 0 : (ph - 1) / 7, k = (ph == 0) ? 0 : ((ph - 1) % 7 + 1);
        {
            switch (k) {
                case 0: phase0(P, smem); break;
                case 1: phase1(P, l, smem); break;
                case 2: phase2(P, l, smem); break;
                case 3: phase3(P, l, smem); break;
                case 4: phase4(P, l, smem); break;
                case 5: phase5(P, l, smem); break;
                case 6: phase6(P, l, smem); break;
                default: phase7(P, l); break;
            }
        }
    }
}

extern "C" void kernel_launch(void* const* d_in, const int* in_sizes, int n_in, void* d_out, int out_size, void* d_ws, size_t ws_size, hipStream_t stream) {
    (void)in_sizes; (void)n_in; (void)out_size; (void)ws_size;
    Params P{};
    for (int i = 0; i < 26; ++i) P.in[i] = (const float*)d_in[i];
    P.out = (float*)d_out;
    P.ws = (unsigned char*)d_ws;
    static int grid_blocks = 0;
    if (!grid_blocks) {
        int dev = 0, cus = 0, per_cu = 0;
        hipGetDevice(&dev);
        hipDeviceGetAttribute(&cus, hipDeviceAttributeMultiprocessorCount, dev);
        hipOccupancyMaxActiveBlocksPerMultiprocessor(&per_cu, mk_fwd, 256, 0);
        if (per_cu > 2) per_cu = 2;
        if (per_cu < 1) per_cu = 1;
        grid_blocks = cus * per_cu;
    }
#if ML
    for (int ph = 0; ph < N_PHASES; ++ph) {
        hipLaunchKernelGGL(mk_fwd, dim3(grid_blocks), dim3(256), 0, stream, P, ph, ph + 1, 0);
    }
#else
    (void)hipMemsetAsync((unsigned char*)d_ws + WS_BAR, 0, 16384, stream);
    int lo = 0, hi = N_PHASES, coop = 1;
    void* args[] = {&P, &lo, &hi, &coop};
    hipError_t e = hipLaunchCooperativeKernel((void*)mk_fwd, dim3(grid_blocks), dim3(256), args, 0, stream);
    if (e != hipSuccess) fprintf(stderr, "cooperative launch failed: %s (grid %d)\n", hipGetErrorString(e), grid_blocks);
#endif
}
```
